# Optimizing an MI355X kernel written in HIP

```python
import math
import jax
import jax.numpy as jnp
from jax import lax
import numpy as np

D_MODEL = 1024
BATCH = 4
SEQ = 4096
DEPTH = 2

GRID_W = 64
CTX_LEN = 256
N_EVEN = (DEPTH + 1) // 2
N_ODD = DEPTH // 2
N_MOD = 6
ATT_WIDTH = D_MODEL // 2
HY_WIDTH = D_MODEL - ATT_WIDTH
ATT_V_DIM = 128
ATT_HEADS = ATT_WIDTH // ATT_V_DIM
ATT_QK_DIM = ATT_V_DIM // 2
Q_COLS = ATT_HEADS * 2 * ATT_QK_DIM
K_COLS = ATT_HEADS * 2 * ATT_QK_DIM
V_COLS = ATT_HEADS * ATT_V_DIM
KV_START = Q_COLS
HY_START = Q_COLS + K_COLS + V_COLS
HY_COLS = 3 * HY_WIDTH
IN_COLS = HY_START + HY_COLS
Q_BLOCK = 128
ROPE_BASE = 10000.0
HY_POS_EMB = 33
HY_FILTER_HIDDEN = 64
HY_SHORT_CONV = 3
HY_DECAY_TARGET = 1e-2
HY_FAST_DECAY_PCT = 0.3
HY_SLOW_DECAY_PCT = 1.5
HY_FILTER_STD = 0.005
POOL_WINDOWS = (2, 4, 8, 16)
POOL_GROUPS = len(POOL_WINDOWS)
POOL_GROUP_DIM = D_MODEL // POOL_GROUPS
D_FF = 4 * D_MODEL
NORM_EPS = 1e-6
SUBLN_EPS = 1e-5

kernel_name = "hybrid_diffattn_hyena_pool_dit_block"


def _rmsnorm(x, g, eps=NORM_EPS):
    xf = x.astype(jnp.float32)
    y = xf * lax.rsqrt(jnp.mean(xf * xf, axis=-1, keepdims=True) + eps)
    return (y * g.astype(jnp.float32)).astype(x.dtype)


def _modulate(h, shift, scale):
    return h * (1 + scale) + shift


def _grid_positions(seq_len):
    rows = seq_len // GRID_W
    t = jnp.arange(rows * GRID_W, dtype=jnp.int32)
    return t // GRID_W, t % GRID_W


def _axial_rope(x, row, col):
    axis_dim = ATT_QK_DIM // 2
    n_freq = axis_dim // 2
    inv = ROPE_BASE ** (-jnp.arange(n_freq, dtype=jnp.float32) / n_freq)

    def rot(xa, pos):
        ang = pos.astype(jnp.float32)[:, None] * inv[None, :]
        cos = jnp.cos(ang)[None, :, None, None, :].astype(x.dtype)
        sin = jnp.sin(ang)[None, :, None, None, :].astype(x.dtype)
        x1, x2 = xa[..., :n_freq], xa[..., n_freq:]
        return jnp.concatenate([x1 * cos - x2 * sin, x1 * sin + x2 * cos], axis=-1)

    return jnp.concatenate([rot(x[..., :axis_dim], row), rot(x[..., axis_dim:], col)], axis=-1)


def _split_q(p):
    b, l = p.shape[0], p.shape[1]
    return p[..., :Q_COLS].reshape(b, l, ATT_HEADS, 2, ATT_QK_DIM)


def _split_kv(kv):
    b, l = kv.shape[0], kv.shape[1]
    k = kv[..., :K_COLS].reshape(b, l, ATT_HEADS, 2, ATT_QK_DIM)
    v = kv[..., K_COLS:].reshape(b, l, ATT_HEADS, ATT_V_DIM)
    return k, v


def _diff_attn(q, k, v, lam):
    s = jnp.einsum("bqhcd,bkhcd->bhcqk", q, k, preferred_element_type=jnp.float32) * (ATT_QK_DIM ** -0.5)
    p = jax.nn.softmax(s, axis=-1)
    w = p[:, :, 0] - lam * p[:, :, 1]
    return jnp.einsum("bhqk,bkhd->bqhd", w.astype(v.dtype), v)


def _diff_attn_blocked(q, k, v, lam):
    b, l = q.shape[0], q.shape[1]
    nb = l // Q_BLOCK
    qb = jnp.moveaxis(q.reshape(b, nb, Q_BLOCK, ATT_HEADS, 2, ATT_QK_DIM), 1, 0)
    out = lax.map(lambda qq: _diff_attn(qq, k, v, lam), qb)
    return jnp.moveaxis(out, 0, 1).reshape(b, l, ATT_HEADS, ATT_V_DIM)


def _diff_post(o, g, lam_init):
    o = _rmsnorm(o, g, SUBLN_EPS) * (1.0 - lam_init)
    return o.reshape(o.shape[0], o.shape[1], ATT_HEADS * ATT_V_DIM)


def _short_conv3(u, w, b):
    up = jnp.pad(u, ((0, 0), (1, 1), (0, 0)))
    return up[:, :-2] * w[0] + up[:, 1:-1] * w[1] + up[:, 2:] * w[2] + b


def _hyena_filter(seq_len, w1, b1, f1, w2, b2, f2, w3):
    t = jnp.linspace(0.0, 1.0, seq_len, dtype=jnp.float32)[:, None]
    bands = (HY_POS_EMB - 1) // 2
    freqs = jnp.linspace(1e-4, bands - 1, bands, dtype=jnp.float32)
    ang = (2.0 * math.pi / seq_len) * jnp.arange(seq_len, dtype=jnp.float32)[:, None] * freqs[None, :]
    z = jnp.concatenate([t, jnp.cos(ang), -jnp.sin(ang)], axis=-1).astype(w1.dtype)
    hdn = jnp.sin(f1 * (z @ w1 + b1))
    hdn = jnp.sin(f2 * (hdn @ w2 + b2))
    h = (hdn @ w3).astype(jnp.float32).reshape(seq_len, 2, HY_WIDTH)
    max_decay = math.log(HY_DECAY_TARGET) / HY_FAST_DECAY_PCT
    min_decay = math.log(HY_DECAY_TARGET) / HY_SLOW_DECAY_PCT
    deltas = jnp.linspace(min_decay, max_decay, HY_WIDTH, dtype=jnp.float32)
    h = h * jnp.exp(-t * jnp.abs(deltas)[None, :])[:, None, :]
    return jnp.concatenate([h[:, 0], jnp.zeros((1, HY_WIDTH), jnp.float32), h[:0:-1, 1]], axis=0)


def _long_conv(u, k2, bias):
    l = u.shape[1]
    uf = u.astype(jnp.float32)
    U = jnp.fft.rfft(uf, n=2 * l, axis=1)
    K = jnp.fft.rfft(k2, axis=0)
    y = jnp.fft.irfft(U * K[None], n=2 * l, axis=1)[:, :l]
    return (y + uf * bias.astype(jnp.float32)).astype(u.dtype)


def _hyena(p, conv_w, conv_b, filt, bias):
    p = _short_conv3(p, conv_w, conv_b)
    x0, x1, v = jnp.split(p, 3, axis=-1)
    return x0 * _long_conv(v * x1, filt, bias)


def _multiscale_pool(u, w, scale):
    b, l, d = u.shape
    uf = u.astype(jnp.float32)
    cs = jnp.concatenate([jnp.zeros((b, 1, d), jnp.float32), jnp.cumsum(uf, axis=1)], axis=1)
    t = jnp.arange(l)
    outs = []
    for g, win in enumerate(POOL_WINDOWS):
        lo = jnp.clip(t - win // 2, 0, l)
        hi = jnp.clip(t + win - win // 2, 0, l)
        sl = slice(g * POOL_GROUP_DIM, (g + 1) * POOL_GROUP_DIM)
        csg = cs[..., sl]
        mean = (csg[:, hi] - csg[:, lo]) / (hi - lo).astype(jnp.float32)[None, :, None]
        outs.append(mean - uf[..., sl])
    dlt = jnp.stack(outs, axis=2).astype(u.dtype)
    y = jnp.einsum("blgc,gcd->blgd", dlt, w).reshape(b, l, d)
    return y * scale


def _sq_relu_mlp(h, w1, w2):
    return jnp.square(jax.nn.relu(h @ w1)) @ w2


def setup_inputs(seed: int = 0) -> dict:
    key = jax.random.key(seed)
    ks = iter(jax.random.split(key, 40))

    def nrm(shape, std):
        return std * jax.random.normal(next(ks), shape, jnp.float32)

    D = D_MODEL
    H = HY_FILTER_HIDDEN
    return {
        "x": nrm((BATCH, SEQ, D), 1.0),
        "c": nrm((BATCH, D), 1.0),
        "ctx": nrm((BATCH, CTX_LEN, D), 1.0),
        "c_ctx": nrm((D,), 1.0),
        "ada_w": nrm((DEPTH, D, N_MOD * D), 0.5 * D ** -0.5),
        "ada_b": nrm((DEPTH, N_MOD * D), 0.02),
        "norm1_g": 1.0 + nrm((DEPTH, D), 0.05),
        "norm2_g": 1.0 + nrm((DEPTH, D), 0.05),
        "mix_w_in": nrm((N_EVEN, D, IN_COLS), D ** -0.5),
        "mix_b_in": nrm((N_EVEN, IN_COLS), 0.02),
        "mix_w_out": nrm((N_EVEN, D, D), D ** -0.5),
        "mix_b_out": nrm((N_EVEN, D), 0.02),
        "lam_q1": nrm((N_EVEN, ATT_QK_DIM), 0.1),
        "lam_k1": nrm((N_EVEN, ATT_QK_DIM), 0.1),
        "lam_q2": nrm((N_EVEN, ATT_QK_DIM), 0.1),
        "lam_k2": nrm((N_EVEN, ATT_QK_DIM), 0.1),
        "subln_g": 1.0 + nrm((N_EVEN, ATT_V_DIM), 0.05),
        "hy_conv_w": nrm((N_EVEN, HY_SHORT_CONV, HY_COLS), HY_SHORT_CONV ** -0.5),
        "hy_conv_b": nrm((N_EVEN, HY_COLS), 0.02),
        "hy_pos_w1": nrm((N_EVEN, HY_POS_EMB, H), HY_POS_EMB ** -0.5),
        "hy_pos_b1": nrm((N_EVEN, H), 0.1),
        "hy_freq1": 1.0 + nrm((N_EVEN, H), 0.1),
        "hy_pos_w2": nrm((N_EVEN, H, H), H ** -0.5),
        "hy_pos_b2": nrm((N_EVEN, H), 0.1),
        "hy_freq2": 1.0 + nrm((N_EVEN, H), 0.1),
        "hy_pos_w3": nrm((N_EVEN, H, 2 * HY_WIDTH), HY_FILTER_STD),
        "hy_bias": nrm((N_EVEN, HY_WIDTH), 0.5),
        "pool_w": nrm((N_ODD, POOL_GROUPS, POOL_GROUP_DIM, POOL_GROUP_DIM), POOL_GROUP_DIM ** -0.5),
        "pool_scale": 1.0 + nrm((N_ODD, D), 0.05),
        "mlp_w1": nrm((DEPTH, D, D_FF), D ** -0.5),
        "mlp_w2": nrm((DEPTH, D_FF, D), D_FF ** -0.5),
        "final_g": 1.0 + nrm((D,), 0.05),
    }


def reference(x, c, ctx, c_ctx, ada_w, ada_b, norm1_g, norm2_g, mix_w_in, mix_b_in, mix_w_out, mix_b_out,
              lam_q1, lam_k1, lam_q2, lam_k2, subln_g, hy_conv_w, hy_conv_b, hy_pos_w1, hy_pos_b1, hy_freq1,
              hy_pos_w2, hy_pos_b2, hy_freq2, hy_pos_w3, hy_bias, pool_w, pool_scale, mlp_w1, mlp_w2, final_g):
    seq_len = x.shape[1]
    row, col = _grid_positions(seq_len)
    s_lat = jax.nn.silu(c)
    s_ctx = jax.nn.silu(c_ctx)
    h_lat, h_ctx = x, ctx
    for i in range(DEPTH):
        ctx_live = any(j % 2 == 0 for j in range(i + 1, DEPTH))
        mod_l = [m[:, None, :] for m in jnp.split(s_lat @ ada_w[i] + ada_b[i], N_MOD, axis=-1)]
        a_lat = _modulate(_rmsnorm(h_lat, norm1_g[i]), mod_l[0], mod_l[1])
        if i % 2 == 0 or ctx_live:
            mod_c = jnp.split(s_ctx @ ada_w[i] + ada_b[i], N_MOD, axis=-1)
            a_ctx = _modulate(_rmsnorm(h_ctx, norm1_g[i]), mod_c[0], mod_c[1])
        if i % 2 == 0:
            e = i // 2
            lam_init = 0.8 - 0.6 * math.exp(-0.3 * i)
            lam = (jnp.exp(jnp.sum(lam_q1[e] * lam_k1[e]).astype(jnp.float32))
                   - jnp.exp(jnp.sum(lam_q2[e] * lam_k2[e]).astype(jnp.float32)) + lam_init)
            filt = (hy_pos_w1[e], hy_pos_b1[e], hy_freq1[e], hy_pos_w2[e], hy_pos_b2[e], hy_freq2[e], hy_pos_w3[e])
            p_lat = a_lat @ mix_w_in[e] + mix_b_in[e]
            q_l = _axial_rope(_split_q(p_lat), row, col)
            k_l, v_l = _split_kv(p_lat[..., KV_START:HY_START])
            k_l = _axial_rope(k_l, row, col)
            if ctx_live:
                p_ctx = a_ctx @ mix_w_in[e] + mix_b_in[e]
                kv_ctx = p_ctx[..., KV_START:HY_START]
            else:
                kv_ctx = a_ctx @ mix_w_in[e][:, KV_START:HY_START] + mix_b_in[e][KV_START:HY_START]
            k_c, v_c = _split_kv(kv_ctx)
            k_all = jnp.concatenate([k_c, k_l], axis=1)
            v_all = jnp.concatenate([v_c, v_l], axis=1)
            att_l = _diff_post(_diff_attn_blocked(q_l, k_all, v_all, lam), subln_g[e], lam_init)
            hy_l = _hyena(p_lat[..., HY_START:], hy_conv_w[e], hy_conv_b[e], _hyena_filter(seq_len, *filt), hy_bias[e])
            y_lat = jnp.concatenate([att_l, hy_l], axis=-1) @ mix_w_out[e] + mix_b_out[e]
            if ctx_live:
                att_c = _diff_post(_diff_attn(_split_q(p_ctx), k_c, v_c, lam), subln_g[e], lam_init)
                hy_c = _hyena(p_ctx[..., HY_START:], hy_conv_w[e], hy_conv_b[e],
                              _hyena_filter(h_ctx.shape[1], *filt), hy_bias[e])
                y_ctx = jnp.concatenate([att_c, hy_c], axis=-1) @ mix_w_out[e] + mix_b_out[e]
        else:
            o = i // 2
            y_lat = _multiscale_pool(a_lat, pool_w[o], pool_scale[o])
            if ctx_live:
                y_ctx = _multiscale_pool(a_ctx, pool_w[o], pool_scale[o])
        h_lat = h_lat + mod_l[2] * y_lat
        h_lat = h_lat + mod_l[5] * _sq_relu_mlp(
            _modulate(_rmsnorm(h_lat, norm2_g[i]), mod_l[3], mod_l[4]), mlp_w1[i], mlp_w2[i])
        if ctx_live:
            h_ctx = h_ctx + mod_c[2] * y_ctx
            h_ctx = h_ctx + mod_c[5] * _sq_relu_mlp(
                _modulate(_rmsnorm(h_ctx, norm2_g[i]), mod_c[3], mod_c[4]), mlp_w1[i], mlp_w2[i])
    return _rmsnorm(h_lat, final_g)
```

```cpp
#include <hip/hip_runtime.h>
#include <stdint.h>

typedef unsigned short bf16_t;
__device__ __forceinline__ float bf2f(bf16_t v) { return __uint_as_float(((unsigned)v) << 16); }
__device__ __forceinline__ bf16_t f2bf(float f) { unsigned u = __float_as_uint(f); return (bf16_t)((u + 0x7fffu + ((u >> 16) & 1u)) >> 16); }

constexpr int D = 1024, NB = 4, L = 4096, M = NB * L, CTX = 256, MC = NB * CTX, NMOD = 6;
constexpr int INC = 3072, FF = 4096, HYW = 512;
constexpr size_t MiB = 1u << 20;
constexpr size_t OFF_MOD0 = 1 * MiB, OFF_MOD1 = 1 * MiB + 128 * 1024, OFF_FILT = 2 * MiB, OFF_XN = 18 * MiB, OFF_XC = 50 * MiB,
                 OFF_KVC = 52 * MiB, OFF_P = 54 * MiB, OFF_Y = 150 * MiB, OFF_H = 54 * MiB, OFF_T = 182 * MiB;

__device__ __forceinline__ float block_sum256(float v, float* red) {
    for (int o = 32; o > 0; o >>= 1) v += __shfl_xor(v, o);
    __syncthreads();
    if ((threadIdx.x & 63) == 0) red[threadIdx.x >> 6] = v;
    __syncthreads();
    return red[0] + red[1] + red[2] + red[3];
}

__global__ __launch_bounds__(256) void k_mod(const float* c, const float* c_ctx, const float* ada_w, const float* ada_b, float* mod0, float* mod1) {
    __shared__ float s[5][1024];
    const int l = blockIdx.y, n = blockIdx.x * 256 + threadIdx.x;
    for (int i = threadIdx.x; i < 5 * 1024; i += 256) { int r = i >> 10, k = i & 1023; float v = r < 4 ? c[r * 1024 + k] : c_ctx[k]; s[r][k] = v / (1.f + __expf(-v)); }
    __syncthreads();
    float acc[5] = {0, 0, 0, 0, 0};
    const float* w = ada_w + (size_t)l * 1024 * 6144 + n;
    for (int k = 0; k < 1024; ++k) { float wv = w[(size_t)k * 6144];
#pragma unroll
        for (int r = 0; r < 5; ++r) acc[r] += s[r][k] * wv; }
    float bb = ada_b[l * 6144 + n];
    if (l == 0) { for (int r = 0; r < 5; ++r) mod0[r * 6144 + n] = acc[r] + bb; }
    else { for (int r = 0; r < 4; ++r) mod1[r * 6144 + n] = acc[r] + bb; }
}

__global__ __launch_bounds__(256) void k_filter(const float* w1, const float* b1, const float* f1, const float* w2, const float* b2, const float* f2, const float* w3, float* G2) {
    __shared__ float z[33], h1[64], h2[64];
    const int j = blockIdx.x, tid = threadIdx.x;
    const float tj = (float)j / 4095.f;
    if (tid == 0) z[0] = tj;
    if (tid >= 1 && tid <= 16) { int i = tid - 1; float fr = 1e-4f + (float)i * ((15.f - 1e-4f) / 15.f); float ang = (6.283185307179586f / 4096.f) * (float)j * fr; z[tid] = cosf(ang); z[tid + 16] = -sinf(ang); }
    __syncthreads();
    if (tid < 64) { float a = b1[tid]; for (int k = 0; k < 33; ++k) a += z[k] * w1[k * 64 + tid]; h1[tid] = sinf(f1[tid] * a); }
    __syncthreads();
    if (tid < 64) { float a = b2[tid]; for (int k = 0; k < 64; ++k) a += h1[k] * w2[k * 64 + tid]; h2[tid] = sinf(f2[tid] * a); }
    __syncthreads();
    const float dmin = logf(1e-2f) / 1.5f, dmax = logf(1e-2f) / 0.3f;
    for (int i = 0; i < 4; ++i) { int o = tid + 256 * i; float a = 0; for (int k = 0; k < 64; ++k) a += h2[k] * w3[k * 1024 + o];
        int dir = o >> 9, cc = o & 511; float dl = fabsf(dmin + (float)cc * ((dmax - dmin) / 511.f)); a *= expf(-tj * dl);
        if (dir == 0) G2[(size_t)(4096 + j) * 512 + cc] = a; else if (j >= 1) G2[(size_t)(4096 - j) * 512 + cc] = a; }
    if (j == 0) { for (int i = tid; i < 512; i += 256) G2[i] = 0.f; }
}

template <typename OT> __global__ __launch_bounds__(256) void k_normmod(const float* x, const float* g, const float* mod, long shift_chunk, long rows_per_b, long fixed_r, OT* out) {
    __shared__ float red[4];
    const int row = blockIdx.x, tid = threadIdx.x;
    const int r = fixed_r >= 0 ? (int)fixed_r : row / (int)rows_per_b;
    const float4 v = ((const float4*)(x + (size_t)row * D))[tid];
    float ss = block_sum256(v.x * v.x + v.y * v.y + v.z * v.z + v.w * v.w, red);
    const float rstd = rsqrtf(ss / (float)D + 1e-6f);
    const float* sh = mod + (size_t)r * 6144 + shift_chunk * 1024, *sc = sh + 1024;
    float vv[4] = {v.x, v.y, v.z, v.w};
    for (int i = 0; i < 4; ++i) { int cidx = tid * 4 + i; float o = vv[i] * rstd * g[cidx] * (1.f + sc[cidx]) + sh[cidx];
        if constexpr (sizeof(OT) == 2) out[(size_t)row * D + cidx] = f2bf(o); else out[(size_t)row * D + cidx] = o; }
}

template <typename AT> __device__ __forceinline__ float ldA(const AT* p) { if constexpr (sizeof(AT) == 2) return bf2f(*p); else return *p; }
template <typename AT, class Epi> __global__ __launch_bounds__(256) void k_gemm(const AT* A, long lda, const float* W, long ldw, long K_, Epi epi) {
    __shared__ float As[16][68], Bs[16][64];
    const int tid = threadIdx.x, tx = tid & 15, ty = tid >> 4, K = (int)K_;
    const int row0 = blockIdx.y * 64, col0 = blockIdx.x * 64;
    A += (size_t)blockIdx.z * epi.a_zoff; W += (size_t)blockIdx.z * epi.w_zoff;
    float acc[4][4] = {};
    for (int k0 = 0; k0 < K; k0 += 16) {
        { int r = tid >> 2, kk = (tid & 3) * 4; const AT* ap = A + (size_t)(row0 + r) * lda + k0 + kk;
          for (int i = 0; i < 4; ++i) As[kk + i][r] = ldA(ap + i); }
        { int kk = tid >> 4, n4 = (tid & 15) * 4; const float4 w = *(const float4*)(W + (size_t)(k0 + kk) * ldw + col0 + n4);
          Bs[kk][n4] = w.x; Bs[kk][n4 + 1] = w.y; Bs[kk][n4 + 2] = w.z; Bs[kk][n4 + 3] = w.w; }
        __syncthreads();
#pragma unroll
        for (int k = 0; k < 16; ++k) { float a[4], b[4];
#pragma unroll
            for (int i = 0; i < 4; ++i) a[i] = As[k][ty * 4 + i];
#pragma unroll
            for (int j = 0; j < 4; ++j) b[j] = Bs[k][tx + 16 * j];
#pragma unroll
            for (int i = 0; i < 4; ++i)
#pragma unroll
                for (int j = 0; j < 4; ++j) acc[i][j] += a[i] * b[j]; }
        __syncthreads();
    }
#pragma unroll
    for (int i = 0; i < 4; ++i) epi.store(row0 + ty * 4 + i, col0, tx, acc[i], blockIdx.z);
}

struct EpiInproj { size_t a_zoff, w_zoff; const float* bias; bf16_t* P;
    __device__ void store(int row, int col0, int tx, float* v, int) const {
        float o[4];
        for (int j = 0; j < 4; ++j) o[j] = v[j] + bias[col0 + tx + 16 * j];
        if (col0 < 1024) {
            const int t = row & (L - 1); const float pr = (float)(t >> 6), pc = (float)(t & 63);
            const float inv = powf(10000.f, -(float)tx / 16.f);
            float cr = cosf(pr * inv), sr = sinf(pr * inv), cc = cosf(pc * inv), sc = sinf(pc * inv);
            float a0 = o[0] * cr - o[1] * sr, a1 = o[0] * sr + o[1] * cr, a2 = o[2] * cc - o[3] * sc, a3 = o[2] * sc + o[3] * cc;
            o[0] = a0; o[1] = a1; o[2] = a2; o[3] = a3;
        }
        for (int j = 0; j < 4; ++j) P[(size_t)row * INC + col0 + tx + 16 * j] = f2bf(o[j]);
    } };
struct EpiBiasBf16 { size_t a_zoff, w_zoff; const float* bias; bf16_t* O; long ldo;
    __device__ void store(int row, int col0, int tx, float* v, int) const { for (int j = 0; j < 4; ++j) { int c = col0 + tx + 16 * j; O[(size_t)row * ldo + c] = f2bf(v[j] + bias[c]); } } };
struct EpiOutproj { size_t a_zoff, w_zoff; const float* bias; const float* x; const float* mod; float* out;
    __device__ void store(int row, int col0, int tx, float* v, int) const { const int b = row / L;
        for (int j = 0; j < 4; ++j) { int c = col0 + tx + 16 * j; out[(size_t)row * D + c] = x[(size_t)row * D + c] + mod[b * 6144 + 2 * 1024 + c] * (v[j] + bias[c]); } } };
struct EpiMlpUp { size_t a_zoff, w_zoff; bf16_t* H;
    __device__ void store(int row, int col0, int tx, float* v, int) const { for (int j = 0; j < 4; ++j) { int c = col0 + tx + 16 * j; float r = fmaxf(v[j], 0.f); H[(size_t)row * FF + c] = f2bf(r * r); } } };
struct EpiMlpDown { size_t a_zoff, w_zoff; const float* mod; float* out;
    __device__ void store(int row, int col0, int tx, float* v, int) const { const int b = row / L;
        for (int j = 0; j < 4; ++j) { int c = col0 + tx + 16 * j; out[(size_t)row * D + c] += mod[b * 6144 + 5 * 1024 + c] * v[j]; } } };
struct EpiPool { size_t a_zoff, w_zoff; const float* mod; const float* pscale; float* out;
    __device__ void store(int row, int col0, int tx, float* v, int g) const { const int b = row / L;
        for (int j = 0; j < 4; ++j) { int c = g * 256 + col0 + tx + 16 * j; out[(size_t)row * D + c] += mod[b * 6144 + 2 * 1024 + c] * v[j] * pscale[c]; } } };

__global__ __launch_bounds__(256) void k_attn(const bf16_t* P, const bf16_t* KVC, float* T) {
    const int qb = blockIdx.x, z = blockIdx.y, half = z & 1, c = (z >> 1) & 1, h = (z >> 2) & 3, b = z >> 4;
    const int q = qb * 256 + threadIdx.x;
    float qv[64], acc[64];
    const bf16_t* qp = P + (size_t)(b * L + q) * INC + h * 128 + c * 64;
#pragma unroll
    for (int d = 0; d < 64; ++d) { qv[d] = bf2f(qp[d]) * 0.125f; acc[d] = 0.f; }
    float m = -1e30f, l = 0.f;
    for (int j = 0; j < CTX + L; ++j) {
        const bf16_t *kp, *vp;
        if (j < CTX) { const bf16_t* base = KVC + (size_t)(b * CTX + j) * 1024; kp = base + h * 128 + c * 64; vp = base + 512 + h * 128 + half * 64; }
        else { const bf16_t* base = P + (size_t)(b * L + j - CTX) * INC; kp = base + 512 + h * 128 + c * 64; vp = base + 1024 + h * 128 + half * 64; }
        float s = 0.f;
#pragma unroll
        for (int d = 0; d < 64; ++d) s += qv[d] * bf2f(kp[d]);
        const float mn = fmaxf(m, s), al = __expf(m - mn), p = __expf(s - mn);
        l = l * al + p; m = mn;
#pragma unroll
        for (int d = 0; d < 64; ++d) acc[d] = acc[d] * al + p * bf2f(vp[d]);
    }
    float* tp = T + ((size_t)((b * 4 + h) * 2 + c) * L + q) * 128 + half * 64;
    const float il = 1.f / l;
#pragma unroll
    for (int d = 0; d < 64; ++d) tp[d] = acc[d] * il;
}
__global__ __launch_bounds__(128) void k_attn_post(const float* T, const float* lq1, const float* lk1, const float* lq2, const float* lk2, const float* sg, bf16_t* Y) {
    __shared__ float red[2]; __shared__ float lam_s;
    const int q = blockIdx.x, bh = blockIdx.y, b = bh >> 2, h = bh & 3, d = threadIdx.x;
    if (d == 0) { float s1 = 0, s2 = 0; for (int i = 0; i < 64; ++i) { s1 += lq1[i] * lk1[i]; s2 += lq2[i] * lk2[i]; } lam_s = expf(s1) - expf(s2) + 0.2f; }
    __syncthreads();
    const float o1 = T[((size_t)(bh * 2 + 0) * L + q) * 128 + d], o2 = T[((size_t)(bh * 2 + 1) * L + q) * 128 + d];
    const float o = o1 - lam_s * o2;
    float ss = o * o; for (int of = 32; of > 0; of >>= 1) ss += __shfl_xor(ss, of);
    if ((d & 63) == 0) red[d >> 6] = ss; __syncthreads(); ss = red[0] + red[1];
    const float rstd = rsqrtf(ss / 128.f + 1e-5f);
    Y[(size_t)(b * L + q) * D + h * 128 + d] = f2bf(o * rstd * sg[d] * 0.8f);
}

__global__ __launch_bounds__(256) void k_hy_pre(const bf16_t* P, const float* cw, const float* cb, float* U, float* X0) {
    const int row = blockIdx.x, t = row & (L - 1);
    for (int c = threadIdx.x; c < 512; c += 256) { float pr[3];
        for (int q = 0; q < 3; ++q) { const int col = q * 512 + c; const bf16_t* p = P + (size_t)row * INC + 1536 + col;
            float a = cb[col] + cw[1536 + col] * bf2f(p[0]);
            if (t > 0) a += cw[col] * bf2f(p[-INC]);
            if (t < L - 1) a += cw[2 * 1536 + col] * bf2f(p[INC]);
            pr[q] = a; }
        X0[(size_t)row * 512 + c] = pr[0]; U[(size_t)row * 512 + c] = pr[2] * pr[1]; }
}
__global__ __launch_bounds__(256) void k_longconv(const float* U, const float* X0, const float* G2, const float* hb, bf16_t* Y) {
    const int t0 = blockIdx.x * 8, c = blockIdx.y * 256 + threadIdx.x, b = blockIdx.z;
    float acc[8] = {};
    const float* up = U + (size_t)b * L * 512 + c;
    for (int s0 = 0; s0 < L; s0 += 8) {
        float u[8], g[15];
#pragma unroll
        for (int i = 0; i < 8; ++i) u[i] = up[(size_t)(s0 + i) * 512];
#pragma unroll
        for (int e = 0; e < 15; ++e) g[e] = G2[(size_t)(t0 - s0 - 7 + e + 4096) * 512 + c];
#pragma unroll
        for (int j = 0; j < 8; ++j)
#pragma unroll
            for (int i = 0; i < 8; ++i) acc[j] += u[i] * g[j - i + 7];
    }
    const float bias = hb[c];
#pragma unroll
    for (int j = 0; j < 8; ++j) { size_t row = (size_t)b * L + t0 + j; float y = acc[j] + bias * up[(size_t)(t0 + j) * 512];
        Y[row * D + 512 + c] = f2bf(X0[row * 512 + c] * y); }
}

__global__ __launch_bounds__(256) void k_pool_dlt(const float* AN, bf16_t* DL) {
    const int row = blockIdx.x, t = row & (L - 1), b = row / L;
    for (int c = threadIdx.x; c < D; c += 256) { const int g = c >> 8, w = 2 << g;
        const int lo = max(t - w / 2, 0), hi = min(t + w / 2, L);
        float s = 0.f; for (int p = lo; p < hi; ++p) s += AN[(size_t)(b * L + p) * D + c];
        DL[(size_t)row * D + c] = f2bf(s / (float)(hi - lo) - AN[(size_t)row * D + c]); }
}
__global__ __launch_bounds__(256) void k_final_norm(float* out, const float* g) {
    __shared__ float red[4];
    const int row = blockIdx.x, tid = threadIdx.x;
    float4 v = ((float4*)(out + (size_t)row * D))[tid];
    float ss = block_sum256(v.x * v.x + v.y * v.y + v.z * v.z + v.w * v.w, red);
    const float rstd = rsqrtf(ss / (float)D + 1e-6f);
    const float4 gv = ((const float4*)g)[tid];
    v.x *= rstd * gv.x; v.y *= rstd * gv.y; v.z *= rstd * gv.z; v.w *= rstd * gv.w;
    ((float4*)(out + (size_t)row * D))[tid] = v;
}

extern "C" void kernel_launch(void* const* d_in, const int* in_sizes, int n_in, void* d_out, int out_size, void* d_ws, size_t ws_size, hipStream_t stream) {
    const float* x = (const float*)d_in[0]; const float* c = (const float*)d_in[1]; const float* ctx = (const float*)d_in[2]; const float* c_ctx = (const float*)d_in[3];
    const float* ada_w = (const float*)d_in[4]; const float* ada_b = (const float*)d_in[5]; const float* norm1_g = (const float*)d_in[6]; const float* norm2_g = (const float*)d_in[7];
    const float* mix_w_in = (const float*)d_in[8]; const float* mix_b_in = (const float*)d_in[9]; const float* mix_w_out = (const float*)d_in[10]; const float* mix_b_out = (const float*)d_in[11];
    const float* lam_q1 = (const float*)d_in[12]; const float* lam_k1 = (const float*)d_in[13]; const float* lam_q2 = (const float*)d_in[14]; const float* lam_k2 = (const float*)d_in[15];
    const float* subln_g = (const float*)d_in[16]; const float* hy_conv_w = (const float*)d_in[17]; const float* hy_conv_b = (const float*)d_in[18];
    const float* hy_pos_w1 = (const float*)d_in[19]; const float* hy_pos_b1 = (const float*)d_in[20]; const float* hy_freq1 = (const float*)d_in[21];
    const float* hy_pos_w2 = (const float*)d_in[22]; const float* hy_pos_b2 = (const float*)d_in[23]; const float* hy_freq2 = (const float*)d_in[24];
    const float* hy_pos_w3 = (const float*)d_in[25]; const float* hy_bias = (const float*)d_in[26]; const float* pool_w = (const float*)d_in[27]; const float* pool_scale = (const float*)d_in[28];
    const float* mlp_w1 = (const float*)d_in[29]; const float* mlp_w2 = (const float*)d_in[30]; const float* final_g = (const float*)d_in[31];
    float* out = (float*)d_out; char* ws = (char*)d_ws;
    float* mod0 = (float*)(ws + OFF_MOD0); float* mod1 = (float*)(ws + OFF_MOD1); float* G2 = (float*)(ws + OFF_FILT);
    bf16_t* XN = (bf16_t*)(ws + OFF_XN); bf16_t* XC = (bf16_t*)(ws + OFF_XC); bf16_t* KVC = (bf16_t*)(ws + OFF_KVC); bf16_t* P = (bf16_t*)(ws + OFF_P);
    bf16_t* Y = (bf16_t*)(ws + OFF_Y); bf16_t* H = (bf16_t*)(ws + OFF_H); float* T = (float*)(ws + OFF_T);
    float* U = T; float* X0 = T + (size_t)M * 512; float* AN = T;

    k_mod<<<dim3(6144 / 256, 2), 256, 0, stream>>>(c, c_ctx, ada_w, ada_b, mod0, mod1);
    k_filter<<<L, 256, 0, stream>>>(hy_pos_w1, hy_pos_b1, hy_freq1, hy_pos_w2, hy_pos_b2, hy_freq2, hy_pos_w3, G2);
    k_normmod<bf16_t><<<M, 256, 0, stream>>>(x, norm1_g, mod0, 0, L, -1, XN);
    k_normmod<bf16_t><<<MC, 256, 0, stream>>>(ctx, norm1_g, mod0, 0, 1, 4, XC);
    k_gemm<bf16_t, EpiInproj><<<dim3(INC / 64, M / 64), 256, 0, stream>>>(XN, D, mix_w_in, INC, D, EpiInproj{0, 0, mix_b_in, P});
    k_gemm<bf16_t, EpiBiasBf16><<<dim3(1024 / 64, MC / 64), 256, 0, stream>>>(XC, D, mix_w_in + 512, INC, D, EpiBiasBf16{0, 0, mix_b_in + 512, KVC, 1024});
    k_attn<<<dim3(L / 256, 64), 256, 0, stream>>>(P, KVC, T);
    k_attn_post<<<dim3(L, 16), 128, 0, stream>>>(T, lam_q1, lam_k1, lam_q2, lam_k2, subln_g, Y);
    k_hy_pre<<<M, 256, 0, stream>>>(P, hy_conv_w, hy_conv_b, U, X0);
    k_longconv<<<dim3(L / 8, 2, NB), 256, 0, stream>>>(U, X0, G2, hy_bias, Y);
    k_gemm<bf16_t, EpiOutproj><<<dim3(D / 64, M / 64), 256, 0, stream>>>(Y, D, mix_w_out, D, D, EpiOutproj{0, 0, mix_b_out, x, mod0, out});
    k_normmod<bf16_t><<<M, 256, 0, stream>>>(out, norm2_g, mod0, 3, L, -1, XN);
    k_gemm<bf16_t, EpiMlpUp><<<dim3(FF / 64, M / 64), 256, 0, stream>>>(XN, D, mlp_w1, FF, D, EpiMlpUp{0, 0, H});
    k_gemm<bf16_t, EpiMlpDown><<<dim3(D / 64, M / 64), 256, 0, stream>>>(H, FF, mlp_w2, D, FF, EpiMlpDown{0, 0, mod0, out});
    k_normmod<float><<<M, 256, 0, stream>>>(out, norm1_g + D, mod1, 0, L, -1, AN);
    k_pool_dlt<<<M, 256, 0, stream>>>(AN, XN);
    k_gemm<bf16_t, EpiPool><<<dim3(256 / 64, M / 64, 4), 256, 0, stream>>>(XN, D, pool_w, 256, 256, EpiPool{256, 65536, mod1, pool_scale, out});
    k_normmod<bf16_t><<<M, 256, 0, stream>>>(out, norm2_g + D, mod1, 3, L, -1, XN);
    k_gemm<bf16_t, EpiMlpUp><<<dim3(FF / 64, M / 64), 256, 0, stream>>>(XN, D, mlp_w1 + (size_t)D * FF, FF, D, EpiMlpUp{0, 0, H});
    k_gemm<bf16_t, EpiMlpDown><<<dim3(D / 64, M / 64), 256, 0, stream>>>(H, FF, mlp_w2 + (size_t)D * FF, D, FF, EpiMlpDown{0, 0, mod1, out});
    k_final_norm<<<M, 256, 0, stream>>>(out, final_g);
}
```

```cpp
#include <hip/hip_runtime.h>
#include <stdint.h>
#include <cstdio>

#define LAS __attribute__((address_space(3)))
#define GAS __attribute__((address_space(1)))
typedef unsigned short bf16_t;
typedef short bf16x8 __attribute__((ext_vector_type(8)));
typedef float f32x4 __attribute__((ext_vector_type(4)));
typedef float f32x2 __attribute__((ext_vector_type(2)));
typedef unsigned u32x4 __attribute__((ext_vector_type(4)));
typedef unsigned u32x2 __attribute__((ext_vector_type(2)));

__device__ __forceinline__ float bf2f(bf16_t v) { return __uint_as_float(((unsigned)v) << 16); }
__device__ __forceinline__ unsigned f2bf(float f) { unsigned u = __float_as_uint(f); return (u + 0x7fffu + ((u >> 16) & 1u)) >> 16; }
__device__ __forceinline__ unsigned pk2(float lo, float hi) { return f2bf(lo) | (f2bf(hi) << 16); }
__device__ __forceinline__ unsigned cvt_pk_bf16(float lo, float hi) { unsigned r; asm volatile("v_cvt_pk_bf16_f32 %0, %1, %2" : "=v"(r) : "v"(lo), "v"(hi)); return r; }

constexpr int D = 1024, NB = 4, L = 4096, M = NB * L, CTX = 256, MC = NB * CTX, KEYS = CTX + L;
constexpr int INC = 3072, FF = 4096;
constexpr int GRLEN = 8208;
constexpr float C2 = 0.125f * 1.4426950408889634f;
constexpr float LAM_INIT = 0.2f;

constexpr size_t MiB = 1u << 20, KiB = 1024;
constexpr size_t CTL_ZERO_BYTES = 1 * MiB;
constexpr int CW_BAR = 4096;
constexpr size_t OFF_MOD0 = 64 * KiB, OFF_MOD1 = 192 * KiB, OFF_SB1 = 320 * KiB, OFF_SSQ = 512 * KiB;
constexpr size_t OFF_ROPE = 1 * MiB;
constexpr size_t OFF_GR = 2 * MiB;
constexpr size_t OFF_WIN = 11 * MiB, OFF_WOUT = 17 * MiB, OFF_W1 = 19 * MiB, OFF_W2 = 35 * MiB, OFF_WPOOL = 51 * MiB;
constexpr size_t OFF_XN = 52 * MiB, OFF_XC = 84 * MiB;
constexpr size_t OFF_H = 86 * MiB, OFF_QB = 86 * MiB, OFF_KALL = 102 * MiB, OFF_VALL = 120 * MiB, OFF_HPT = 138 * MiB;
constexpr size_t OFF_Y = 214 * MiB;
constexpr size_t WS_END = 246 * MiB;

constexpr int RING_BYTES = 131072, MISC_OFF = 143360, LDS_BYTES = 147456;

namespace pg8 {
constexpr int BM = 256, BK = 64, HALF = 128, HTB = HALF * BK * 2, NXCD = 8, WGM = 8;
__host__ __device__ __forceinline__ int lds_byte(int r, int c) { const int st = (r >> 4) * 2 + (c >> 5), rr = r & 15, cc = c & 31, ob = rr * 64 + cc * 2; return st * 1024 + (ob ^ (((ob >> 9) & 1) << 5)); }
__host__ __device__ __forceinline__ void stage_rc(int b, int& R, int& C) { const int st = b / 1024, sb = b % 1024, swz = sb ^ (((sb >> 9) & 1) << 5); R = (st >> 1) * 16 + swz / 64; C = (st & 1) * 32 + (swz % 64) / 2; }
__host__ __device__ __forceinline__ int perm32(int rho) { const int n = rho >> 4, i = rho & 15; return 8 * (i >> 2) + 4 * n + (i & 3); }

struct Unit { int pm, pn, kind; };
struct Gemm { const bf16_t* A; const bf16_t* Bt; const bf16_t* A2; const bf16_t* Bt2; int lda, ldb, K, a_koff; };
struct Sched {
    int nM, nN, nwg, G, c, extra, pn_off;
    __device__ void init(int M_, int N_, int G_, int c_, int extra_, int pn_off_ = 0) { nM = M_ / BM; nN = N_ / BM; nwg = nM * nN; G = G_; c = c_; extra = extra_; pn_off = pn_off_; }
    __device__ bool next(int i, Unit& u) const {
        const long Lx = (long)i * G + c; if (Lx >= nwg + extra) return false;
        if (Lx >= nwg) { const int e = (int)Lx - nwg; u.pm = e >> 2; u.pn = e & 3; u.kind = 1; return true; }
        int wgid = (int)Lx; { const int q = nwg / NXCD, r = nwg % NXCD, xcd = wgid % NXCD, off = wgid / NXCD; wgid = (xcd < r ? xcd * (q + 1) : r * (q + 1) + (xcd - r) * q) + off; }
        const int nig = WGM * nN, gid = wgid / nig, fm = gid * WGM, gsz = (nM - fm) < WGM ? (nM - fm) : WGM;
        u.pm = fm + ((wgid % nig) % gsz); u.pn = pn_off + (wgid % nig) / gsz; u.kind = 0; return true;
    }
};

template <class Epi, bool SWP = false>
__device__ __forceinline__ void gemm_phase(LAS unsigned char* lds, const Gemm g, const Sched& S, const Epi& E) {
    const int tid = threadIdx.x, wid = __builtin_amdgcn_readfirstlane(tid >> 6), lane = tid & 63, wr = wid >> 2, wc = wid & 3, fr = lane & 15, fq = lane >> 4;
    const int K = g.K, nt = K / BK;
    unsigned voffA[2], voffB[2];
#pragma unroll
    for (int i = 0; i < 2; ++i) { int R, C; stage_rc(tid * 16 + i * 8192, R, C); const int Rb = Epi::PERM ? ((R & ~31) + perm32(R & 31)) : R;
        voffA[i] = (unsigned)(R * g.lda + C) * 2u; voffB[i] = (unsigned)(Rb * g.ldb + C) * 2u; }
    const size_t kstep = (size_t)(BK * 2);
    const size_t hstepA = (size_t)HALF * g.lda * 2, hstepB = (size_t)HALF * g.ldb * 2, tstepA = 2 * hstepA, tstepB = 2 * hstepB;
    const unsigned ldsw = (unsigned)wid * 1024u;
    const int aoff = lds_byte(wr * 64 + fr, fq * 8), boff = lds_byte(wc * 32 + fr, fq * 8);
#define PG8_SA(b, h) (((b) * 2 + (h)) * HTB)
#define PG8_SB(b, h) ((4 + (b) * 2 + (h)) * HTB)
#define PG8_STAGE(bufoff, gbase, voff) do { _Pragma("unroll") for (int _i = 0; _i < 2; ++_i) \
        __builtin_amdgcn_global_load_lds((const unsigned*)((const char*)(gbase) + (voff)[_i]), (LAS unsigned*)(lds + (bufoff) + ldsw + _i * 8192), 16, 0, 0); } while (0)
#define PG8_LDA(dst, b, h) do { _Pragma("unroll") for (int m = 0; m < 4; ++m) _Pragma("unroll") for (int k = 0; k < 2; ++k) dst[m][k] = *(const LAS bf16x8*)(lds + PG8_SA(b, h) + aoff + m * 2048 + k * 1024); } while (0)
#define PG8_LDB(dst, b, h) do { _Pragma("unroll") for (int n = 0; n < 2; ++n) _Pragma("unroll") for (int k = 0; k < 2; ++k) dst[n][k] = *(const LAS bf16x8*)(lds + PG8_SB(b, h) + boff + n * 2048 + k * 1024); } while (0)
#define PG8_MMA(ai, bj, At, Bt) do { __builtin_amdgcn_s_setprio(1); \
        if constexpr (SWP) { _Pragma("unroll") for (int m = 0; m < 4; ++m) _Pragma("unroll") for (int n = 0; n < 2; ++n) _Pragma("unroll") for (int k = 0; k < 2; ++k) \
            acc[ai][bj][m][n] = __builtin_amdgcn_mfma_f32_16x16x32_bf16(At[m][k], Bt[n][k], acc[ai][bj][m][n], 0, 0, 0); } \
        else { _Pragma("unroll") for (int m = 0; m < 4; ++m) _Pragma("unroll") for (int n = 0; n < 2; ++n) _Pragma("unroll") for (int k = 0; k < 2; ++k) \
            acc[ai][bj][m][n] = __builtin_amdgcn_mfma_f32_16x16x32_bf16(Bt[n][k], At[m][k], acc[ai][bj][m][n], 0, 0, 0); } \
        __builtin_amdgcn_s_setprio(0); } while (0)
#define PG8_WAIT_V(n) asm volatile("s_waitcnt vmcnt(" #n ")" ::: "memory")
#define PG8_WAIT_L(n) asm volatile("s_waitcnt lgkmcnt(" #n ")" ::: "memory")
#define PG8_BAR __builtin_amdgcn_s_barrier()
#define PG8_SCHED __builtin_amdgcn_sched_barrier(0)
#define PG8_PTRS(u, pa, pb) do { pa = (const char*)((u).kind ? g.A2 : g.A) + (size_t)(u).pm * tstepA + (size_t)((u).pn * g.a_koff) * 2; pb = (const char*)((u).kind ? g.Bt2 : g.Bt) + (size_t)(u).pn * tstepB; } while (0)
    Unit cur, nxt; int ui = 0;
    if (!S.next(0, cur)) return;
    f32x4 acc[2][2][4][2];
#pragma unroll
    for (int a = 0; a < 2; ++a)
#pragma unroll
        for (int b = 0; b < 2; ++b)
#pragma unroll
            for (int m = 0; m < 4; ++m)
#pragma unroll
                for (int n = 0; n < 2; ++n) acc[a][b][m][n] = (f32x4){0.f, 0.f, 0.f, 0.f};
    bf16x8 At[4][2], B0[2][2], B1[2][2];
    const char *cA, *cB; PG8_PTRS(cur, cA, cB);
    PG8_STAGE(PG8_SB(0, 0), cB, voffB); PG8_STAGE(PG8_SB(0, 1), cB + hstepB, voffB); PG8_STAGE(PG8_SA(0, 0), cA, voffA); PG8_STAGE(PG8_SA(0, 1), cA + hstepA, voffA);
    if (wr == 1) PG8_BAR;
    PG8_WAIT_V(2); PG8_BAR;
    PG8_STAGE(PG8_SB(1, 0), cB + kstep, voffB); PG8_STAGE(PG8_SA(1, 0), cA + kstep, voffA); PG8_STAGE(PG8_SB(1, 1), cB + hstepB + kstep, voffB);
    PG8_WAIT_V(6); PG8_BAR;
    for (;;) {
        const bool has_next = S.next(ui + 1, nxt);
        const char *nA = cA, *nB = cB; if (has_next) PG8_PTRS(nxt, nA, nB);
        for (int t = 0; t < nt; t += 2) {
            const bool last = (t == nt - 2);
            const char* a1 = cA + (size_t)(t + 1) * kstep;
            const char* a2 = last ? nA : cA + (size_t)(t + 2) * kstep; const char* b2 = last ? nB : cB + (size_t)(t + 2) * kstep;
            const char* a3 = a2 + kstep; const char* b3 = b2 + kstep;
            PG8_LDB(B0, 0, 0); PG8_LDB(B1, 0, 1); PG8_SCHED; PG8_LDA(At, 0, 0); PG8_STAGE(PG8_SA(1, 1), a1 + hstepA, voffA);
            PG8_WAIT_V(8); PG8_WAIT_L(0); PG8_BAR; PG8_MMA(0, 0, At, B0); PG8_MMA(0, 1, At, B1); PG8_BAR; PG8_SCHED;
            PG8_LDA(At, 0, 1); PG8_STAGE(PG8_SB(0, 0), b2, voffB); PG8_STAGE(PG8_SB(0, 1), b2 + hstepB, voffB); PG8_STAGE(PG8_SA(0, 0), a2, voffA);
            PG8_WAIT_V(8); PG8_WAIT_L(0); PG8_BAR; PG8_MMA(1, 0, At, B0); PG8_MMA(1, 1, At, B1); PG8_BAR; PG8_SCHED;
            PG8_LDB(B0, 1, 0); PG8_LDB(B1, 1, 1); PG8_SCHED; PG8_LDA(At, 1, 0); PG8_STAGE(PG8_SA(0, 1), a2 + hstepA, voffA);
            PG8_WAIT_V(8); PG8_WAIT_L(0); PG8_BAR; PG8_MMA(0, 0, At, B0); PG8_MMA(0, 1, At, B1); PG8_BAR; PG8_SCHED;
            PG8_LDA(At, 1, 1); PG8_STAGE(PG8_SB(1, 0), b3, voffB); PG8_STAGE(PG8_SB(1, 1), b3 + hstepB, voffB); PG8_STAGE(PG8_SA(1, 0), a3, voffA);
            PG8_WAIT_V(8); PG8_WAIT_L(0); PG8_BAR; PG8_MMA(1, 0, At, B0); PG8_MMA(1, 1, At, B1); PG8_BAR; PG8_SCHED;
        }
        if (wr == 0) PG8_BAR;
        E(acc, cur, wr, wc, fr, fq);
        if (!has_next) break;
#pragma unroll
        for (int a = 0; a < 2; ++a)
#pragma unroll
            for (int b = 0; b < 2; ++b)
#pragma unroll
                for (int m = 0; m < 4; ++m)
#pragma unroll
                    for (int n = 0; n < 2; ++n) acc[a][b][m][n] = (f32x4){0.f, 0.f, 0.f, 0.f};
        cur = nxt; cA = nA; cB = nB; ++ui;
        if (wr == 1) PG8_BAR;
    }
    PG8_WAIT_V(0);
    PG8_BAR;
#undef PG8_SA
#undef PG8_SB
#undef PG8_STAGE
#undef PG8_LDA
#undef PG8_LDB
#undef PG8_MMA
#undef PG8_WAIT_V
#undef PG8_WAIT_L
#undef PG8_BAR
#undef PG8_SCHED
#undef PG8_PTRS
}

struct EpiHy {
    static constexpr bool PERM = false;
    const float* bias; bf16_t* HPT;
    __device__ __forceinline__ void operator()(const f32x4 (&acc)[2][2][4][2], const Unit& u, int wr, int wc, int fr, int fq) const {
        const int ch0 = (u.pn - 6) * BM + wc * 32 + fr;
#pragma unroll
        for (int bj = 0; bj < 2; ++bj)
#pragma unroll
            for (int n = 0; n < 2; ++n) { const int ch = ch0 + bj * HALF + 16 * n; const float bv = bias[1536 + ch];
                bf16_t* cp = HPT + (size_t)ch * M + u.pm * BM + wr * 64 + 4 * fq;
#pragma unroll
                for (int ai = 0; ai < 2; ++ai)
#pragma unroll
                    for (int m = 0; m < 4; ++m) { const f32x4 v = acc[ai][bj][m][n] + bv; u32x2 w; w.x = cvt_pk_bf16(v[0], v[1]); w.y = cvt_pk_bf16(v[2], v[3]);
                        *(u32x2*)(cp + ai * HALF + m * 16) = w; } }
    }
};
struct EpiInproj {
    static constexpr bool PERM = true;
    const float* bias; const f32x2* rope; unsigned char* ws;
    __device__ __forceinline__ void operator()(const f32x4 (&acc)[2][2][4][2], const Unit& u, int wr, int wc, int fr, int fq) const {
        const int colt = (u.kind ? 512 : 0) + u.pn * BM;
        const int sect = colt >> 9;
        const bool do_rope = (u.kind == 0) && sect < 2;
        bf16_t* base = (bf16_t*)(ws + (sect == 0 ? OFF_QB : (sect == 1 ? OFF_KALL : OFF_VALL)));
        const int lcol0 = (colt & 511) + wc * 32 + 8 * fq;
        const float sc = sect == 0 ? C2 : 1.f;
        const float* bp = bias + colt + wc * 32 + 8 * fq;
#pragma unroll
        for (int ai = 0; ai < 2; ++ai)
#pragma unroll
            for (int m = 0; m < 4; ++m) {
                const int r = u.pm * BM + ai * HALF + wr * 64 + m * 16 + fr;
                size_t orow;
                if (sect == 0) orow = (size_t)r;
                else if (u.kind == 0) orow = (size_t)(r >> 12) * KEYS + CTX + (r & (L - 1));
                else orow = (size_t)(r >> 8) * KEYS + (r & (CTX - 1));
                const int t = r & (L - 1), pos = (wc & 1) ? (t & 63) : (t >> 6);
                const f32x4* rp = (const f32x4*)(rope + pos * 16 + 8 * (fq & 1));
#pragma unroll
                for (int bj = 0; bj < 2; ++bj) {
                    f32x4 v0 = acc[ai][bj][m][0] + *(const f32x4*)(bp + bj * HALF), v1 = acc[ai][bj][m][1] + *(const f32x4*)(bp + bj * HALF + 4);
                    if (do_rope) {
                        const f32x4 c0 = rp[0], c1 = rp[1], c2 = rp[2], c3 = rp[3];
                        f32x4 p0, p1;
#pragma unroll
                        for (int e = 0; e < 4; ++e) { p0[e] = __shfl_xor(v0[e], 32); p1[e] = __shfl_xor(v1[e], 32); }
                        const float sg = (fq < 2) ? -1.f : 1.f;
                        v0 = (f32x4){v0[0] * c0[0] + sg * p0[0] * c0[1], v0[1] * c0[2] + sg * p0[1] * c0[3], v0[2] * c1[0] + sg * p0[2] * c1[1], v0[3] * c1[2] + sg * p0[3] * c1[3]};
                        v1 = (f32x4){v1[0] * c2[0] + sg * p1[0] * c2[1], v1[1] * c2[2] + sg * p1[1] * c2[3], v1[2] * c3[0] + sg * p1[2] * c3[1], v1[3] * c3[2] + sg * p1[3] * c3[3]};
                    }
                    v0 = v0 * sc; v1 = v1 * sc;
                    u32x4 w; w.x = cvt_pk_bf16(v0[0], v0[1]); w.y = cvt_pk_bf16(v0[2], v0[3]); w.z = cvt_pk_bf16(v1[0], v1[1]); w.w = cvt_pk_bf16(v1[2], v1[3]);
                    *(u32x4*)(base + orow * 512 + lcol0 + bj * HALF) = w;
                }
                asm volatile("" ::: "memory");
            }
    }
};
struct EpiResid {
    static constexpr bool PERM = false;
    const float* resid; float* out; const float* bias; const float* cscale; const float* mod; int gate_chunk; const float* ng; int scale_chunk; bf16_t* xn; float* ssq;
    __device__ __forceinline__ void operator()(const f32x4 (&acc)[2][2][4][2], const Unit& u, int wr, int wc, int fr, int fq) const {
        const int b = u.pm >> 4;
        const int col0 = u.pn * BM + wc * 32 + 4 * fq;
        f32x4 gt[2][2], bs[2][2], gs[2][2];
#pragma unroll
        for (int bj = 0; bj < 2; ++bj)
#pragma unroll
            for (int n = 0; n < 2; ++n) { const int c = col0 + bj * HALF + n * 16;
                gt[bj][n] = *(const f32x4*)(mod + b * 6144 + gate_chunk * 1024 + c);
                if (cscale) gt[bj][n] = gt[bj][n] * *(const f32x4*)(cscale + c);
                bs[bj][n] = bias ? *(const f32x4*)(bias + c) : (f32x4){0.f, 0.f, 0.f, 0.f};
                if (xn) gs[bj][n] = *(const f32x4*)(ng + c) * (*(const f32x4*)(mod + b * 6144 + scale_chunk * 1024 + c) + 1.f); }
#pragma unroll
        for (int ai = 0; ai < 2; ++ai)
#pragma unroll
            for (int m = 0; m < 4; ++m) { const int r = u.pm * BM + ai * HALF + wr * 64 + m * 16 + fr; const size_t off = (size_t)r * D + col0; float q = 0.f;
#pragma unroll
                for (int bj = 0; bj < 2; ++bj)
#pragma unroll
                    for (int n = 0; n < 2; ++n) { const size_t o2 = off + bj * HALF + n * 16;
                        const f32x4 h = *(const f32x4*)(resid + o2) + gt[bj][n] * (acc[ai][bj][m][n] + bs[bj][n]);
                        *(f32x4*)(out + o2) = h; q += (h[0] * h[0] + h[1] * h[1]) + (h[2] * h[2] + h[3] * h[3]);
                        if (xn) { const f32x4 a = h * gs[bj][n]; u32x2 w; w.x = cvt_pk_bf16(a[0], a[1]); w.y = cvt_pk_bf16(a[2], a[3]); *(u32x2*)(xn + o2) = w; } }
                q += __shfl_xor(q, 16); q += __shfl_xor(q, 32);
                if (fq == 0) atomicAdd(ssq + r, q); }
    }
};
struct EpiMlpUp {
    static constexpr bool PERM = true;
    const float* ssq; const float* sb1; bf16_t* H;
    __device__ __forceinline__ void operator()(const f32x4 (&acc)[2][2][4][2], const Unit& u, int wr, int wc, int fr, int fq) const {
        const int b = u.pm >> 4; const int col0 = u.pn * BM + wc * 32 + 8 * fq;
        f32x4 sb[2][2];
#pragma unroll
        for (int bj = 0; bj < 2; ++bj)
#pragma unroll
            for (int n = 0; n < 2; ++n) sb[bj][n] = *(const f32x4*)(sb1 + b * FF + col0 + bj * HALF + 4 * n);
#pragma unroll
        for (int ai = 0; ai < 2; ++ai)
#pragma unroll
            for (int m = 0; m < 4; ++m) { const int r = u.pm * BM + ai * HALF + wr * 64 + m * 16 + fr;
                const float rstd = rsqrtf(ssq[r] * (1.f / D) + 1e-6f);
#pragma unroll
                for (int bj = 0; bj < 2; ++bj) { f32x4 v0 = acc[ai][bj][m][0] * rstd + sb[bj][0], v1 = acc[ai][bj][m][1] * rstd + sb[bj][1];
#pragma unroll
                    for (int e = 0; e < 4; ++e) { v0[e] = fmaxf(v0[e], 0.f); v0[e] *= v0[e]; v1[e] = fmaxf(v1[e], 0.f); v1[e] *= v1[e]; }
                    u32x4 w; w.x = cvt_pk_bf16(v0[0], v0[1]); w.y = cvt_pk_bf16(v0[2], v0[3]); w.z = cvt_pk_bf16(v1[0], v1[1]); w.w = cvt_pk_bf16(v1[2], v1[3]);
                    *(u32x4*)(H + (size_t)r * FF + col0 + bj * HALF) = w; } }
    }
};
}

#define XB_TMO      128
#define XB_XCNT(j)  (256  + 64 * (j))
#define XB_XSUB(j)  (1280 + 64 * (j))
#define XB_XGEN(j)  (2304 + 64 * (j))
#define XB_TOP      3328
#define XB_TOPGEN   3392
#define XCD_BAR_WORDS 3456
#define XB_SPIN_CAP (1u << 18)
__device__ __forceinline__ unsigned xb_ld(unsigned* p)              { return __hip_atomic_load(p, __ATOMIC_RELAXED, __HIP_MEMORY_SCOPE_AGENT); }
__device__ __forceinline__ unsigned xb_add(unsigned* p, unsigned v) { return __hip_atomic_fetch_add(p, v, __ATOMIC_RELAXED, __HIP_MEMORY_SCOPE_AGENT); }
__device__ __forceinline__ unsigned xb_xcc_id() { return (unsigned)__builtin_amdgcn_s_getreg((3 << 11) | 20) & 0xFu; }
#define XB_SPIN(cond, bar) do { unsigned _sp = 0; while (cond) { __builtin_amdgcn_s_sleep(1); \
    if ((++_sp & 255u) == 0u) { if (xb_ld(&(bar)[XB_TMO])) break; if (_sp > XB_SPIN_CAP) { atomicAdd(&(bar)[XB_TMO], 1u); break; } } } } while (0)
struct XcdBarrier { unsigned* bar; unsigned x; volatile LAS unsigned* st; };
__device__ __forceinline__ XcdBarrier xcd_barrier_post(unsigned* bar, volatile LAS unsigned* st) {
    XcdBarrier b; b.bar = bar; b.x = xb_xcc_id(); b.st = st;
    if (threadIdx.x == 0) (void)xb_add(&bar[XB_XCNT(b.x)], 1u);
    return b;
}
__device__ __forceinline__ void xcd_barrier_complete(unsigned* bar, unsigned x, unsigned& nloc, unsigned& nx) {
    const unsigned G = gridDim.x * gridDim.y * gridDim.z;
    unsigned sum, cnt, mine, sp = 0u;
    for (;;) {
        sum = 0u; cnt = 0u; mine = 0u;
#pragma unroll
        for (unsigned j = 0; j < 16; ++j) { const unsigned c = xb_ld(&bar[XB_XCNT(j)]); sum += c; cnt += (c > 0u) ? 1u : 0u; mine = (j == x) ? c : mine; }
        if (sum == G) break;
        __builtin_amdgcn_s_sleep(1);
        if ((++sp & 255u) == 0u) { if (xb_ld(&bar[XB_TMO])) break; if (sp > XB_SPIN_CAP) { atomicAdd(&bar[XB_TMO], 1u); break; } }
    }
    nloc = mine > 0u ? mine : 1u; nx = cnt > 0u ? cnt : 1u;
}
__device__ __forceinline__ void xcd_barrier(const XcdBarrier& b) {
    asm volatile("s_waitcnt vmcnt(0)" ::: "memory");
    __syncthreads();
    if (threadIdx.x == 0) {
        unsigned* bar = b.bar;
        __builtin_amdgcn_s_waitcnt(0);
        unsigned nloc = b.st[0], nx = b.st[1];
        if (nloc == 0u) { xcd_barrier_complete(bar, b.x, nloc, nx); b.st[0] = nloc; b.st[1] = nx; }
        const unsigned old = xb_add(&bar[XB_XSUB(b.x)], 1u);
        const unsigned gen = old / nloc;
        if (old + 1u == (gen + 1u) * nloc) {
            __builtin_amdgcn_fence(__ATOMIC_RELEASE, "agent");
            asm volatile("s_waitcnt vmcnt(0)" ::: "memory");
            const unsigned og = xb_add(&bar[XB_TOP], 1u);
            const unsigned tg = og / nx;
            if (og + 1u == (tg + 1u) * nx) xb_add(&bar[XB_TOPGEN], 1u);
            else XB_SPIN(xb_ld(&bar[XB_TOPGEN]) == tg, bar);
            __builtin_amdgcn_fence(__ATOMIC_ACQUIRE, "agent");
            xb_add(&bar[XB_XGEN(b.x)], 1u);
            asm volatile("s_waitcnt vmcnt(0)" ::: "memory");
        } else {
            XB_SPIN(xb_ld(&bar[XB_XGEN(b.x)]) == gen, bar);
            __builtin_amdgcn_fence(__ATOMIC_ACQUIRE, "agent");
            asm volatile("s_waitcnt vmcnt(0)" ::: "memory");
        }
    }
    __syncthreads();
}

struct Args { const float* in[32]; float* out; unsigned char* ws; int ph_lo, ph_hi, li, pad; };
struct Frame {
    LAS unsigned char* lds; int tid, lane, wave, G, bid; unsigned char* ws; float* out;
    const float *x, *c, *ctx, *c_ctx, *ada_w, *ada_b, *norm1_g, *norm2_g, *w_in, *b_in, *w_out, *b_out, *lq1, *lk1, *lq2, *lk2, *subln_g, *hy_cw, *hy_cb,
        *hy_w1, *hy_b1, *hy_f1, *hy_w2, *hy_b2, *hy_f2, *hy_w3, *hy_bias, *pool_w, *pool_scale, *mlp_w1, *mlp_w2, *final_g;
    float *MOD0, *MOD1, *SB1, *SSQ; f32x2* ROPE; bf16_t *GR, *WIN, *WOUT, *W1, *W2, *WPOOL, *XN, *XC, *QB, *KALL, *VALL, *HPT, *Y, *H;
};
#define LDS_WAIT() asm volatile("s_waitcnt lgkmcnt(0)" ::: "memory")
__device__ __forceinline__ float wave_sum(float v) {
#pragma unroll
    for (int o = 1; o < 64; o <<= 1) v += __shfl_xor(v, o);
    return v;
}
__device__ __forceinline__ void transpose_item(const float* W, int K, int N, bf16_t* WT, int item, LAS float* scr, int lane, const float* shiftmod, float* sbout) {
    const int nblk = N / 32, kb = item / nblk, nb = item % nblk, k0 = 64 * kb, n0 = 32 * nb;
#pragma unroll 8
    for (int i = 0; i < 32; ++i) { const int kk = 2 * i + (lane >> 5); scr[kk * 33 + (lane & 31)] = W[(size_t)(k0 + kk) * N + n0 + (lane & 31)]; }
    if (shiftmod) {
#pragma unroll
        for (int b = 0; b < 4; ++b) scr[64 * 33 + b * 64 + lane] = shiftmod[b * 6144 + k0 + lane];
    }
    LDS_WAIT(); asm volatile("" ::: "memory");
    const int c = lane & 7;
#pragma unroll
    for (int j = 0; j < 4; ++j) { const int n = (lane >> 3) + 8 * j; const LAS float* s = scr + (8 * c) * 33 + n;
        u32x4 o; o.x = pk2(s[0 * 33], s[1 * 33]); o.y = pk2(s[2 * 33], s[3 * 33]); o.z = pk2(s[4 * 33], s[5 * 33]); o.w = pk2(s[6 * 33], s[7 * 33]);
        *(u32x4*)(WT + (size_t)(n0 + n) * K + k0 + 8 * c) = o; }
    if (shiftmod) { const int n = lane & 31, bb = (lane >> 5) * 2; float p0 = 0.f, p1 = 0.f;
        for (int kk = 0; kk < 64; ++kk) { const float w = scr[kk * 33 + n]; p0 += scr[64 * 33 + bb * 64 + kk] * w; p1 += scr[64 * 33 + (bb + 1) * 64 + kk] * w; }
        atomicAdd(sbout + bb * N + n0 + n, p0); atomicAdd(sbout + (bb + 1) * N + n0 + n, p1); }
    LDS_WAIT(); asm volatile("" ::: "memory");
}
__device__ __forceinline__ void normmod_row(const float* xrow, const float* g, const float* shift, const float* scale, bf16_t* orow, int lane) {
    const f32x4* xr = (const f32x4*)xrow + lane; f32x4 v[4]; float s = 0.f;
#pragma unroll
    for (int j = 0; j < 4; ++j) { v[j] = xr[64 * j]; s += (v[j][0] * v[j][0] + v[j][1] * v[j][1]) + (v[j][2] * v[j][2] + v[j][3] * v[j][3]); }
    const float rstd = rsqrtf(wave_sum(s) * (1.f / D) + 1e-6f);
#pragma unroll
    for (int j = 0; j < 4; ++j) { const int c = 4 * lane + 256 * j; const f32x4 gg = *(const f32x4*)(g + c), sh = *(const f32x4*)(shift + c), sc = *(const f32x4*)(scale + c);
        const f32x4 o = v[j] * rstd * gg * (sc + 1.f) + sh; u32x2 w; w.x = cvt_pk_bf16(o[0], o[1]); w.y = cvt_pk_bf16(o[2], o[3]); *(u32x2*)(orow + c) = w; }
}

__device__ __forceinline__ void phase0a(Frame& F) {
    LAS float* scr = (LAS float*)(F.lds + F.wave * 16384);
    const int gw = F.bid * 8 + F.wave, NGW = F.G * 8, lane = F.lane;
    for (int it = gw; it < 2 * 96 * 8; it += NGW) {
        const int l = it / 768, rem = it % 768, cg = rem >> 3, ks = rem & 7;
        for (int i = lane; i < 128; i += 64) { const int k = ks * 128 + i;
#pragma unroll
            for (int r = 0; r < 5; ++r) { const float v = r < 4 ? F.c[r * 1024 + k] : F.c_ctx[k]; scr[r * 128 + i] = v / (1.f + __expf(-v)); } }
        LDS_WAIT(); asm volatile("" ::: "memory");
        const int col = cg * 64 + lane; const float* W = F.ada_w + (size_t)l * 1024 * 6144 + (size_t)(ks * 128) * 6144 + col;
        float a0 = 0.f, a1 = 0.f, a2 = 0.f, a3 = 0.f, a4 = 0.f;
#pragma unroll 8
        for (int i = 0; i < 128; ++i) { const float w = W[(size_t)i * 6144]; a0 += scr[i] * w; a1 += scr[128 + i] * w; a2 += scr[256 + i] * w; a3 += scr[384 + i] * w; a4 += scr[512 + i] * w; }
        if (ks == 0) { const float bb = F.ada_b[l * 6144 + col]; a0 += bb; a1 += bb; a2 += bb; a3 += bb; a4 += bb; }
        float* Mo = l == 0 ? F.MOD0 : F.MOD1;
        atomicAdd(Mo + col, a0); atomicAdd(Mo + 6144 + col, a1); atomicAdd(Mo + 2 * 6144 + col, a2); atomicAdd(Mo + 3 * 6144 + col, a3);
        if (l == 0) atomicAdd(Mo + 4 * 6144 + col, a4);
        LDS_WAIT(); asm volatile("" ::: "memory");
    }
    {
        constexpr int I_IN = 16 * 96, I_OUT = 16 * 32, I_W2 = 64 * 32, I_P = 4 * 8;
        constexpr int NIT = I_IN + I_OUT + 2 * I_W2 + 4 * I_P;
        for (int it = gw; it < NIT; it += NGW) { int r = it;
            if (r < I_IN) { transpose_item(F.w_in, 1024, 3072, F.WIN, r, scr, lane, nullptr, nullptr); continue; } r -= I_IN;
            if (r < I_OUT) { transpose_item(F.w_out, 1024, 1024, F.WOUT, r, scr, lane, nullptr, nullptr); continue; } r -= I_OUT;
            if (r < 2 * I_W2) { const int l = r / I_W2; transpose_item(F.mlp_w2 + (size_t)l * FF * D, FF, D, F.W2 + (size_t)l * FF * D, r % I_W2, scr, lane, nullptr, nullptr); continue; } r -= 2 * I_W2;
            { const int gI = r / I_P; transpose_item(F.pool_w + (size_t)gI * 65536, 256, 256, F.WPOOL + (size_t)gI * 65536, r % I_P, scr, lane, nullptr, nullptr); }
        }
    }
    for (int i = gw * 64 + lane; i < 64 * 16; i += NGW * 64) { const int pos = i >> 4, fi = i & 15; const float ang = (float)pos * powf(10000.f, -(float)fi / 16.f); F.ROPE[i] = (f32x2){cosf(ang), sinf(ang)}; }
    for (int it = gw; it < 512; it += NGW) {
        const int j0 = it * 8;
        LAS float* zs = scr; LAS float* h1s = scr + 9 * 33; LAS float* h2s = h1s + 9 * 64;
        for (int p = 0; p < 9; ++p) { const int j = j0 + p; const float tj = (float)j / 4095.f;
            if (lane == 0) zs[p * 33] = tj;
            if (lane >= 1 && lane <= 16) { const int i = lane - 1; const float fr_ = 1e-4f + (float)i * ((15.f - 1e-4f) / 15.f); const float ang = (6.283185307179586f / 4096.f) * (float)j * fr_;
                zs[p * 33 + lane] = cosf(ang); zs[p * 33 + lane + 16] = -sinf(ang); } }
        LDS_WAIT(); asm volatile("" ::: "memory");
        for (int p = 0; p < 9; ++p) { float a = F.hy_b1[lane]; for (int k = 0; k < 33; ++k) a += zs[p * 33 + k] * F.hy_w1[k * 64 + lane]; h1s[p * 64 + lane] = sinf(F.hy_f1[lane] * a); }
        LDS_WAIT(); asm volatile("" ::: "memory");
        for (int p = 0; p < 9; ++p) { float a = F.hy_b2[lane]; for (int k = 0; k < 64; ++k) a += h1s[p * 64 + k] * F.hy_w2[k * 64 + lane]; h2s[p * 64 + lane] = sinf(F.hy_f2[lane] * a); }
        LDS_WAIT(); asm volatile("" ::: "memory");
        const float dmin = logf(1e-2f) / 1.5f, dmax = logf(1e-2f) / 0.3f;
        for (int i = 0; i < 16; ++i) { const int o = lane + 64 * i, dir = o >> 9, cc = o & 511;
            float a[9];
#pragma unroll
            for (int p = 0; p < 9; ++p) a[p] = 0.f;
            for (int k = 0; k < 64; ++k) { const float w = F.hy_w3[k * 1024 + o];
#pragma unroll
                for (int p = 0; p < 9; ++p) a[p] += h2s[p * 64 + k] * w; }
            const float dl = fabsf(dmin + (float)cc * ((dmax - dmin) / 511.f));
#pragma unroll
            for (int p = 0; p < 9; ++p) { const int j = j0 + p; a[p] = (j < L) ? a[p] * expf(-((float)j / 4095.f) * dl) : 0.f; }
            if (dir == 0 && j0 == 0) a[0] += F.hy_bias[cc];
            u32x4 w;
            if (dir == 0) { w.x = pk2(a[7], a[6]); w.y = pk2(a[5], a[4]); w.z = pk2(a[3], a[2]); w.w = pk2(a[1], a[0]); *(u32x4*)(F.GR + (size_t)cc * GRLEN + (4096 - j0)) = w; }
            else          { w.x = pk2(a[1], a[2]); w.y = pk2(a[3], a[4]); w.z = pk2(a[5], a[6]); w.w = pk2(a[7], a[8]); *(u32x4*)(F.GR + (size_t)cc * GRLEN + (4104 + j0)) = w; }
        }
        LDS_WAIT(); asm volatile("" ::: "memory");
    }
}
__device__ __forceinline__ void phase0b(Frame& F) {
    LAS float* scr = (LAS float*)(F.lds + F.wave * 16384);
    const int lane = F.lane;
    if (F.bid < 16) {
        const int pm = F.bid >> 2;
        for (int r = F.wave; r < 256; r += 8) { const int row = pm * 256 + r; normmod_row(F.ctx + (size_t)row * D, F.norm1_g, F.MOD0 + 4 * 6144, F.MOD0 + 4 * 6144 + 1024, F.XC + (size_t)row * D, lane); }
        asm volatile("s_waitcnt vmcnt(0)" ::: "memory"); __syncthreads();
        pg8::Gemm g{nullptr, nullptr, F.XC, F.WIN + (size_t)512 * D, D, D, D, 0};
        pg8::Sched S; S.nM = 0; S.nN = 1; S.nwg = 0; S.G = 1 << 20; S.c = F.bid; S.extra = 16;
        pg8::EpiInproj E{F.b_in, F.ROPE, F.ws};
        pg8::gemm_phase<pg8::EpiInproj>(F.lds, g, S, E);
        return;
    }
    const int gw = (F.bid - 16) * 8 + F.wave, NGW = (F.G - 16) * 8;
    for (int row = gw; row < M; row += NGW) { const int b = row >> 12; normmod_row(F.x + (size_t)row * D, F.norm1_g, F.MOD0 + b * 6144, F.MOD0 + b * 6144 + 1024, F.XN + (size_t)row * D, lane); }
    for (int it = gw; it < 2 * 2048; it += NGW) { const int l = it >> 11;
        transpose_item(F.mlp_w1 + (size_t)l * D * FF, D, FF, F.W1 + (size_t)l * D * FF, it & 2047, scr, lane, (l == 0 ? F.MOD0 : F.MOD1) + 3 * 1024, F.SB1 + l * 4 * FF); }
}

__device__ __forceinline__ void phase_dlt(Frame& F) {
    const int gw = F.bid * 8 + F.wave, NGW = F.G * 8, lane = F.lane;
    const float* ssq = F.SSQ + 1 * M; const float* g1 = F.norm1_g + D;
    const int ch = lane * 16, grp = lane >> 4, hw = 1 << grp;
    for (int row = gw; row < M; row += NGW) {
        const int b = row >> 12, t = row & (L - 1), lo = max(t - hw, 0), hi = min(t + hw, L);
        f32x4 s[4] = {}; f32x4 cur[4] = {};
        for (int p = lo; p < hi; ++p) { const int pr = (b << 12) + p; const float rstd = rsqrtf(ssq[pr] * (1.f / D) + 1e-6f); const f32x4* hp = (const f32x4*)(F.out + (size_t)pr * D + ch);
#pragma unroll
            for (int q = 0; q < 4; ++q) { const f32x4 v = hp[q] * rstd; s[q] += v; if (p == t) cur[q] = v; } }
        const float inv = 1.f / (float)(hi - lo);
        const float* sc = F.MOD1 + b * 6144 + 1024 + ch;
        u32x4 w0, w1;
        f32x4 o[4];
#pragma unroll
        for (int q = 0; q < 4; ++q) o[q] = (s[q] * inv - cur[q]) * (*(const f32x4*)(g1 + ch + 4 * q)) * (*(const f32x4*)(sc + 4 * q) + 1.f);
        w0.x = cvt_pk_bf16(o[0][0], o[0][1]); w0.y = cvt_pk_bf16(o[0][2], o[0][3]); w0.z = cvt_pk_bf16(o[1][0], o[1][1]); w0.w = cvt_pk_bf16(o[1][2], o[1][3]);
        w1.x = cvt_pk_bf16(o[2][0], o[2][1]); w1.y = cvt_pk_bf16(o[2][2], o[2][3]); w1.z = cvt_pk_bf16(o[3][0], o[3][1]); w1.w = cvt_pk_bf16(o[3][2], o[3][3]);
        u32x4* dp = (u32x4*)(F.XN + (size_t)row * D + ch); dp[0] = w0; dp[1] = w1;
    }
}
__device__ __forceinline__ void phase_final(Frame& F) {
    const int gw = F.bid * 8 + F.wave, NGW = F.G * 8, lane = F.lane;
    const float* ssq = F.SSQ + 3 * M;
    for (int row = gw; row < M; row += NGW) { const float rstd = rsqrtf(ssq[row] * (1.f / D) + 1e-6f); f32x4* op = (f32x4*)(F.out + (size_t)row * D) + lane;
#pragma unroll
        for (int j = 0; j < 4; ++j) op[64 * j] = op[64 * j] * rstd * *(const f32x4*)(F.final_g + 4 * lane + 256 * j); }
}


namespace att {
typedef short s16x4 __attribute__((ext_vector_type(4)));
typedef float f32x16 __attribute__((ext_vector_type(16)));
constexpr int SHM_V = 16384, SHM_K = 16384, LDS_WS = 65536, LDS_X = 65536 + 2048;
constexpr float THRL = 11.5f;
#define KSWZ(row, colB) ((row) * 256 + ((colB) ^ (((row) & 7) << 4)))
#define SBAR() __builtin_amdgcn_sched_barrier(0)
__device__ __forceinline__ int crow(int r, int hi) { return (r & 3) + 8 * (r >> 2) + 4 * hi; }
__device__ __forceinline__ void partialSM(f32x16& p0, f32x16& p1, float& m_reg, float& alpha) {
  float pmax = p0[0];
#pragma unroll
  for (int r = 1; r < 16; ++r) pmax = fmaxf(pmax, p0[r]);
#pragma unroll
  for (int r = 0; r < 16; ++r) pmax = fmaxf(pmax, p1[r]);
  { auto rr = __builtin_amdgcn_permlane32_swap(__float_as_uint(pmax), __float_as_uint(pmax), false, false);
    pmax = fmaxf(__uint_as_float(rr[0]), __uint_as_float(rr[1])); }
  float mn;
  if (__builtin_expect(__all(pmax - m_reg <= THRL), 1)) { mn = m_reg; alpha = 1.f; }
  else { mn = fmaxf(m_reg, pmax); alpha = __builtin_amdgcn_exp2f(m_reg - mn); m_reg = mn; }
#pragma unroll
  for (int r = 0; r < 16; ++r) p0[r] = p0[r] - mn;
#pragma unroll
  for (int r = 0; r < 16; ++r) p1[r] = p1[r] - mn;
#pragma unroll
  for (int r = 0; r < 16; ++r) p0[r] = __builtin_amdgcn_exp2f(p0[r]);
}
__device__ __forceinline__ void finishSM(f32x16& p0, f32x16& p1, float alpha, float& l_reg, bf16x8& pa0, bf16x8& pa1, bf16x8& pa2, bf16x8& pa3) {
#pragma unroll
  for (int r = 0; r < 16; ++r) p1[r] = __builtin_amdgcn_exp2f(p1[r]);
  float ps = 0;
#pragma unroll
  for (int r = 0; r < 16; ++r) ps += p0[r];
#pragma unroll
  for (int r = 0; r < 16; ++r) ps += p1[r];
  { auto rr = __builtin_amdgcn_permlane32_swap(__float_as_uint(ps), __float_as_uint(ps), false, false);
    ps = __uint_as_float(rr[0]) + __uint_as_float(rr[1]); }
  l_reg = l_reg * alpha + ps;
#define PK4(P, BASE, OUT) do { unsigned a0 = cvt_pk_bf16(P[BASE + 0], P[BASE + 1]), a1 = cvt_pk_bf16(P[BASE + 2], P[BASE + 3]);   \
    unsigned b0 = cvt_pk_bf16(P[BASE + 4], P[BASE + 5]), b1 = cvt_pk_bf16(P[BASE + 6], P[BASE + 7]);                              \
    auto r0 = __builtin_amdgcn_permlane32_swap(a0, b0, false, false); auto r1 = __builtin_amdgcn_permlane32_swap(a1, b1, false, false); \
    u32x4 w = {r0[0], r1[0], r0[1], r1[1]}; OUT = *reinterpret_cast<bf16x8*>(&w); } while (0)
  PK4(p0, 0, pa0); PK4(p0, 8, pa1); PK4(p1, 0, pa2); PK4(p1, 8, pa3);
#undef PK4
}
__device__ __forceinline__ void qkt(f32x16& p0, f32x16& p1, const LAS unsigned char* Ks, const bf16x8* qr, int r32, int hi, int cbase) {
#pragma unroll
  for (int r = 0; r < 16; ++r) { p0[r] = 0.f; p1[r] = 0.f; }
#pragma unroll
  for (int d0 = 0; d0 < 4; ++d0) { const int cb = cbase + (d0 * 16 + hi * 8) * 2;
    const bf16x8 b0 = *(const LAS bf16x8*)(Ks + KSWZ(r32, cb));
    const bf16x8 b1 = *(const LAS bf16x8*)(Ks + KSWZ(32 + r32, cb));
    p0 = __builtin_amdgcn_mfma_f32_32x32x16_bf16(b0, qr[d0], p0, 0, 0, 0);
    p1 = __builtin_amdgcn_mfma_f32_32x32x16_bf16(b1, qr[d0], p1, 0, 0, 0); }
}
__device__ __forceinline__ int v_st(int k, int c) { const int kk = (k & ~0xC) | ((k & 4) << 1) | ((k & 8) >> 1); return ((kk >> 3) * 4 + (c >> 5)) * 512 + ((kk & 7) * 32 + (c & 31)) * 2; }
__device__ __forceinline__ int v_rd_base(int lane) { return ((lane & 3) << 3) | (((lane >> 2) & 3) << 6) | (((lane >> 4) & 1) << 5) | (((lane >> 5) & 1) << 8); }
constexpr int v_rd_off(int d0, int ks, int half) { return d0 * 512 + ks * 4096 + half * 2048; }
template <int OFF> __device__ __forceinline__ s16x4 tr_read(int vb) {
  s16x4 r; asm volatile("ds_read_b64_tr_b16 %0, %1 offset:%2" : "=&v"(r) : "v"(vb), "i"(OFF) : "memory"); return r;
}
template <int D0> __device__ __forceinline__ void pv_one(f32x16& od, int vb, bf16x8 pa0, bf16x8 pa1, bf16x8 pa2, bf16x8 pa3) {
  const s16x4 l0 = tr_read<v_rd_off(D0, 0, 0)>(vb), h0 = tr_read<v_rd_off(D0, 0, 1)>(vb), l1 = tr_read<v_rd_off(D0, 1, 0)>(vb), h1 = tr_read<v_rd_off(D0, 1, 1)>(vb);
  const s16x4 l2 = tr_read<v_rd_off(D0, 2, 0)>(vb), h2 = tr_read<v_rd_off(D0, 2, 1)>(vb), l3 = tr_read<v_rd_off(D0, 3, 0)>(vb), h3 = tr_read<v_rd_off(D0, 3, 1)>(vb);
  asm volatile("s_waitcnt lgkmcnt(0)" ::: "memory"); SBAR();
#define PK(Lx, Hx) (bf16x8){Lx[0], Lx[1], Lx[2], Lx[3], Hx[0], Hx[1], Hx[2], Hx[3]}
  od = __builtin_amdgcn_mfma_f32_32x32x16_bf16(pa0, PK(l0, h0), od, 0, 0, 0);
  od = __builtin_amdgcn_mfma_f32_32x32x16_bf16(pa1, PK(l1, h1), od, 0, 0, 0);
  od = __builtin_amdgcn_mfma_f32_32x32x16_bf16(pa2, PK(l2, h2), od, 0, 0, 0);
  od = __builtin_amdgcn_mfma_f32_32x32x16_bf16(pa3, PK(l3, h3), od, 0, 0, 0);
#undef PK
}
__device__ __forceinline__ void pv_d0(f32x16* o, int vb, bf16x8 pa0, bf16x8 pa1, bf16x8 pa2, bf16x8 pa3) {
  pv_one<0>(o[0], vb, pa0, pa1, pa2, pa3); pv_one<1>(o[1], vb, pa0, pa1, pa2, pa3); pv_one<2>(o[2], vb, pa0, pa1, pa2, pa3); pv_one<3>(o[3], vb, pa0, pa1, pa2, pa3);
}
__device__ __forceinline__ void attn_unit(const bf16_t* __restrict__ Qb, const bf16_t* __restrict__ Kh, const bf16_t* __restrict__ Vh, bf16_t* __restrict__ Yb,
                                          float lam, const float* __restrict__ sg, LAS unsigned char* lds) {
  constexpr int LDK = 512, NT = KEYS / 64;
  const int tid = threadIdx.x, lane = tid & 63, r32 = lane & 31, hi = lane >> 5; const int wid = __builtin_amdgcn_readfirstlane(tid >> 6);
  const int qblk = wid >> 1, csub = wid & 1, cbase = csub * 128;
  LAS unsigned char* V_lds = lds; LAS unsigned char* K_lds = lds + 2 * SHM_V;
  LAS float* wsf = (LAS float*)(lds + LDS_WS) + wid * 64; LAS float* li_l = wsf; LAS float* al_l = wsf + 32;
  float m_reg = -1e30f, l_reg = 0.f; f32x16 o[4]; bf16x8 qr[4];
#pragma unroll
  for (int d = 0; d < 4; ++d)
#pragma unroll
    for (int r = 0; r < 16; ++r) o[d][r] = 0.f;
  const bf16_t* Qw = Qb + (size_t)(qblk * 32 + r32) * 512 + csub * 64 + hi * 8;
#pragma unroll
  for (int d0 = 0; d0 < 4; ++d0) qr[d0] = *(const bf16x8*)(Qw + d0 * 16);
  const int sr = tid >> 4, sc = (tid & 15) * 8, vst0 = v_st(sr, sc), vst1 = v_st(32 + sr, sc);
  const int vb0 = (int)(unsigned)(uintptr_t)V_lds + v_rd_base(lane);
  bf16x8 s0v0, s0v1, s0k0, s0k1, s1v0, s1v1, s1k0, s1k1;
#define SLOAD0(k0) do { s0v0 = *(const bf16x8*)(&Vh[(size_t)((k0) + sr) * LDK + sc]); s0v1 = *(const bf16x8*)(&Vh[(size_t)((k0) + 32 + sr) * LDK + sc]); \
    s0k0 = *(const bf16x8*)(&Kh[(size_t)((k0) + sr) * LDK + sc]); s0k1 = *(const bf16x8*)(&Kh[(size_t)((k0) + 32 + sr) * LDK + sc]); } while (0)
#define SLOAD1(k0) do { s1v0 = *(const bf16x8*)(&Vh[(size_t)((k0) + sr) * LDK + sc]); s1v1 = *(const bf16x8*)(&Vh[(size_t)((k0) + 32 + sr) * LDK + sc]); \
    s1k0 = *(const bf16x8*)(&Kh[(size_t)((k0) + sr) * LDK + sc]); s1k1 = *(const bf16x8*)(&Kh[(size_t)((k0) + 32 + sr) * LDK + sc]); } while (0)
#define SWRITE0(b) do { *(LAS bf16x8*)(V_lds + (b) * SHM_V + vst0) = s0v0; *(LAS bf16x8*)(V_lds + (b) * SHM_V + vst1) = s0v1; const int kc = sc * 2; \
    *(LAS bf16x8*)(K_lds + (b) * SHM_K + KSWZ(sr, kc)) = s0k0; *(LAS bf16x8*)(K_lds + (b) * SHM_K + KSWZ(32 + sr, kc)) = s0k1; } while (0)
#define SWRITE1(b) do { *(LAS bf16x8*)(V_lds + (b) * SHM_V + vst0) = s1v0; *(LAS bf16x8*)(V_lds + (b) * SHM_V + vst1) = s1v1; const int kc = sc * 2; \
    *(LAS bf16x8*)(K_lds + (b) * SHM_K + KSWZ(sr, kc)) = s1k0; *(LAS bf16x8*)(K_lds + (b) * SHM_K + KSWZ(32 + sr, kc)) = s1k1; } while (0)
#define SWAIT() asm volatile("s_waitcnt vmcnt(4)" ::: "memory")
#define RESC(a) do { if (__any((a) < 1.f)) { if (hi == 0) al_l[r32] = (a); asm volatile("s_waitcnt lgkmcnt(0)" ::: "memory"); \
    _Pragma("unroll") for (int d = 0; d < 4; ++d) _Pragma("unroll") for (int r = 0; r < 16; ++r) o[d][r] *= al_l[crow(r, hi)]; } } while (0)
  f32x16 pA0, pA1, pB0, pB1; float alA, alB; bf16x8 pa0, pa1, pa2, pa3;
  SLOAD0(0); asm volatile("s_waitcnt vmcnt(0)" ::: "memory"); SWRITE0(0); __syncthreads();
  qkt(pA0, pA1, K_lds, qr, r32, hi, cbase); partialSM(pA0, pA1, m_reg, alA);
  SLOAD1(64); SLOAD0(128);
  SWAIT(); SWRITE1(1); __syncthreads();
  for (int j = 1; j + 1 < NT; j += 2) {
    SBAR(); qkt(pB0, pB1, K_lds + SHM_K, qr, r32, hi, cbase);
    finishSM(pA0, pA1, alA, l_reg, pa0, pa1, pa2, pa3); SBAR();
    SLOAD1((j + 2) * 64); SBAR();
    pv_d0(o, vb0, pa0, pa1, pa2, pa3); partialSM(pB0, pB1, m_reg, alB);
    __syncthreads(); SWAIT(); SWRITE0(0);
    RESC(alB); __syncthreads();
    SBAR(); qkt(pA0, pA1, K_lds, qr, r32, hi, cbase);
    finishSM(pB0, pB1, alB, l_reg, pa0, pa1, pa2, pa3); SBAR();
    if (j + 3 < NT) SLOAD0((j + 3) * 64); SBAR();
    pv_d0(o, vb0 + SHM_V, pa0, pa1, pa2, pa3); partialSM(pA0, pA1, m_reg, alA);
    __syncthreads(); SWAIT(); SWRITE1(1);
    RESC(alA); __syncthreads();
  }
  SBAR(); qkt(pB0, pB1, K_lds + SHM_K, qr, r32, hi, cbase);
  finishSM(pA0, pA1, alA, l_reg, pa0, pa1, pa2, pa3); SBAR();
  pv_d0(o, vb0, pa0, pa1, pa2, pa3); partialSM(pB0, pB1, m_reg, alB);
  __syncthreads(); RESC(alB);
  finishSM(pB0, pB1, alB, l_reg, pa0, pa1, pa2, pa3); SBAR();
  pv_d0(o, vb0 + SHM_V, pa0, pa1, pa2, pa3);
  if (hi == 0) li_l[r32] = l_reg; asm volatile("s_waitcnt lgkmcnt(0)" ::: "memory");
  float rli[16];
#pragma unroll
  for (int r = 0; r < 16; ++r) rli[r] = __builtin_amdgcn_rcpf(li_l[crow(r, hi)]);
  LAS float* X = (LAS float*)(lds + LDS_X) + qblk * 4096;
  if (csub == 1) {
#pragma unroll
    for (int d0 = 0; d0 < 4; ++d0)
#pragma unroll
      for (int r = 0; r < 16; ++r) X[(d0 * 16 + r) * 64 + lane] = o[d0][r] * (rli[r] * lam);
  }
  __syncthreads();
  if (csub == 0) {
    float ssq[16];
#pragma unroll
    for (int r = 0; r < 16; ++r) { float s = 0.f;
#pragma unroll
      for (int d0 = 0; d0 < 4; ++d0) { const float v = o[d0][r] * rli[r] - X[(d0 * 16 + r) * 64 + lane]; o[d0][r] = v; s += v * v; }
      ssq[r] = s; }
#pragma unroll
    for (int r = 0; r < 16; ++r) { float s = ssq[r]; s += __shfl_xor(s, 1); s += __shfl_xor(s, 2); s += __shfl_xor(s, 4); s += __shfl_xor(s, 8); s += __shfl_xor(s, 16);
      ssq[r] = rsqrtf(s * (1.f / 128.f) + 1e-5f) * (1.f - LAM_INIT); }
    asm volatile("s_waitcnt lgkmcnt(0)" ::: "memory");
    LAS bf16_t* stg = (LAS bf16_t*)X;
#pragma unroll
    for (int d0 = 0; d0 < 4; ++d0) { const float gv = sg[d0 * 32 + r32];
#pragma unroll
      for (int r = 0; r < 16; ++r) stg[crow(r, hi) * 128 + d0 * 32 + r32] = (bf16_t)f2bf(o[d0][r] * ssq[r] * gv); }
    asm volatile("s_waitcnt lgkmcnt(0)" ::: "memory");
    bf16_t* Yw = Yb + (size_t)(qblk * 32) * D;
#pragma unroll
    for (int i = 0; i < 8; ++i) { const int row = i * 4 + (lane >> 4), ch = lane & 15; const u32x4 v = *(const LAS u32x4*)(stg + row * 128 + ch * 8); *(u32x4*)(Yw + (size_t)row * D + ch * 8) = v; }
  }
  asm volatile("s_waitcnt lgkmcnt(0)" ::: "memory");
  __syncthreads();
#undef SLOAD0
#undef SLOAD1
#undef SWRITE0
#undef SWRITE1
#undef SWAIT
#undef RESC
}
#undef KSWZ
#undef SBAR
}
__device__ __forceinline__ void phase_attn(Frame& F) {
  float s1 = 0.f, s2 = 0.f;
  for (int i = 0; i < 64; ++i) { s1 += F.lq1[i] * F.lk1[i]; s2 += F.lq2[i] * F.lk2[i]; }
  const float lam = expf(s1) - expf(s2) + LAM_INIT;
  for (int uu = F.bid; uu < 512; uu += F.G) {
    const int x = uu & 7, j = (uu >> 3) & 31, k = uu >> 8, bh = 2 * x + k, b = bh >> 2, h = bh & 3, q0 = j * 128;
    att::attn_unit(F.QB + (size_t)(b * L + q0) * 512 + h * 128, F.KALL + (size_t)b * KEYS * 512 + h * 128, F.VALL + (size_t)b * KEYS * 512 + h * 128,
                   F.Y + (size_t)(b * L + q0) * D + h * 128, lam, F.subln_g, F.lds);
  }
}


namespace hy {
typedef float f32x16 __attribute__((ext_vector_type(16)));
constexpr int E_OFF = 0, O_OFF = 16416, UT_OFF = 32832, RS = 144, UT_B = 128 * RS, OUT0_OFF = UT_OFF + 4 * UT_B;
__device__ __forceinline__ int crow(int r, int hi) { return (r & 3) + 8 * (r >> 2) + 4 * hi; }
__device__ __forceinline__ bf16x8 ldA(const LAS unsigned char* p) { const LAS unsigned* q = (const LAS unsigned*)p; u32x4 w = {q[0], q[1], q[2], q[3]}; return __builtin_bit_cast(bf16x8, w); }
__device__ __forceinline__ void conv32(const u32x4* w, float prev, float next, float c0, float c1, float c2, float cb, float* out) {
  float x[34]; x[0] = prev; x[33] = next;
#pragma unroll
  for (int i = 0; i < 4; ++i) {
#pragma unroll
    for (int e = 0; e < 4; ++e) { const unsigned v = w[i][e]; x[1 + i * 8 + e * 2] = __uint_as_float(v << 16); x[2 + i * 8 + e * 2] = __uint_as_float(v & 0xffff0000u); } }
#pragma unroll
  for (int i = 0; i < 32; ++i) out[i] = cb + c0 * x[i] + c1 * x[i + 1] + c2 * x[i + 2];
}
__device__ __forceinline__ void channel(Frame& F, int c, int which  , int cpair0) {
  LAS unsigned char* lds = F.lds;
  const int tid = F.tid, lane = F.lane, r32 = lane & 31, hi = lane >> 5, wid = F.wave;
  for (int i = tid; i < 4 * UT_B / 16; i += 512) *(LAS u32x4*)(lds + UT_OFF + i * 16) = (u32x4){0u, 0u, 0u, 0u};
  { const bf16_t* g = F.GR + (size_t)c * GRLEN;
    for (int k = tid; k < GRLEN / 8; k += 512) { const u32x4 w = *(const u32x4*)(g + 8 * k); const unsigned nx = (k + 1 < GRLEN / 8) ? (unsigned)g[8 * k + 8] : 0u;
      *(LAS u32x4*)(lds + E_OFF + k * 16) = w;
      u32x4 o; o.x = (w.x >> 16) | (w.y << 16); o.y = (w.y >> 16) | (w.z << 16); o.z = (w.z >> 16) | (w.w << 16); o.w = (w.w >> 16) | (nx << 16);
      *(LAS u32x4*)(lds + O_OFF + k * 16) = o; } }
  __syncthreads();
  {
    const int b = tid >> 7, tl = (tid & 127) * 32; const size_t g0 = (size_t)b * L + tl;
    const bf16_t* x1r = F.HPT + (size_t)(512 + c) * M + g0; const bf16_t* vr = F.HPT + (size_t)(1024 + c) * M + g0;
    u32x4 wx[4], wv[4];
#pragma unroll
    for (int i = 0; i < 4; ++i) { wx[i] = *(const u32x4*)(x1r + 8 * i); wv[i] = *(const u32x4*)(vr + 8 * i); }
    const float px = tl > 0 ? bf2f(x1r[-1]) : 0.f, nx = tl + 32 < L ? bf2f(x1r[32]) : 0.f, pv = tl > 0 ? bf2f(vr[-1]) : 0.f, nv = tl + 32 < L ? bf2f(vr[32]) : 0.f;
    float a[32], bq[32];
    conv32(wx, px, nx, F.hy_cw[512 + c], F.hy_cw[1536 + 512 + c], F.hy_cw[3072 + 512 + c], F.hy_cb[512 + c], a);
    conv32(wv, pv, nv, F.hy_cw[1024 + c], F.hy_cw[1536 + 1024 + c], F.hy_cw[3072 + 1024 + c], F.hy_cb[1024 + c], bq);
    LAS unsigned char* dst = lds + UT_OFF + b * UT_B + (32 + (tl >> 6)) * RS + (tl & 63) * 2;
#pragma unroll
    for (int i = 0; i < 4; ++i) { u32x4 o; o.x = cvt_pk_bf16(a[8 * i] * bq[8 * i], a[8 * i + 1] * bq[8 * i + 1]); o.y = cvt_pk_bf16(a[8 * i + 2] * bq[8 * i + 2], a[8 * i + 3] * bq[8 * i + 3]);
      o.z = cvt_pk_bf16(a[8 * i + 4] * bq[8 * i + 4], a[8 * i + 5] * bq[8 * i + 5]); o.w = cvt_pk_bf16(a[8 * i + 6] * bq[8 * i + 6], a[8 * i + 7] * bq[8 * i + 7]);
      *(LAS u32x4*)(dst + 16 * i) = o; }
  }
  __syncthreads();
  const int t1b = wid & 1, dq = wid >> 1;
  const int dlo = t1b ? -31 : -63, d_begin = dlo + 24 * dq, d_end = (dq == 3) ? dlo + 95 : d_begin + 24;
  const int eb = 4103 - r32 + 8 * hi;
  const LAS unsigned char* LA = lds + ((eb & 1) ? O_OFF : E_OFF) + (eb & ~1) * 2;
  const LAS unsigned char* LB = lds + UT_OFF + (32 + 32 * t1b + r32) * RS + 16 * hi;
  f32x16 acc[2][4];
#pragma unroll
  for (int mi = 0; mi < 2; ++mi)
#pragma unroll
    for (int b = 0; b < 4; ++b)
#pragma unroll
      for (int r = 0; r < 16; ++r) acc[mi][b][r] = 0.f;
  bf16x8 Fq[6];
  Fq[4] = ldA(LA - 32 * (4 * d_begin - 3)); Fq[5] = ldA(LA - 32 * (4 * d_begin - 2));
  for (int d1 = d_begin; d1 < d_end; ++d1) {
    const int q0 = 4 * d1;
    Fq[0] = Fq[4]; Fq[1] = Fq[5];
    Fq[2] = ldA(LA - 32 * (q0 - 1)); Fq[3] = ldA(LA - 32 * q0); Fq[4] = ldA(LA - 32 * (q0 + 1)); Fq[5] = ldA(LA - 32 * (q0 + 2));
    const LAS unsigned char* bp = LB - d1 * RS;
#pragma unroll
    for (int b = 0; b < 4; ++b) {
      bf16x8 Bf[4];
#pragma unroll
      for (int ki = 0; ki < 4; ++ki) Bf[ki] = *(const LAS bf16x8*)(bp + b * UT_B + 32 * ki);
#pragma unroll
      for (int ki = 0; ki < 4; ++ki) {
        acc[0][b] = __builtin_amdgcn_mfma_f32_32x32x16_bf16(Fq[3 - ki], Bf[ki], acc[0][b], 0, 0, 0);
        acc[1][b] = __builtin_amdgcn_mfma_f32_32x32x16_bf16(Fq[5 - ki], Bf[ki], acc[1][b], 0, 0, 0); }
    }
  }
  __syncthreads();
  LAS float* R = (LAS float*)(lds + UT_OFF);
  LAS bf16_t* OUT0 = (LAS bf16_t*)(lds + OUT0_OFF);
  const float xw0 = F.hy_cw[c], xw1 = F.hy_cw[1536 + c], xw2 = F.hy_cw[3072 + c], xcb = F.hy_cb[c];
  const int tt1b = wid & 1, tmi = (wid >> 1) & 1, rh = wid >> 2;
#pragma unroll 1
  for (int b = 0; b < 4; ++b) {
#pragma unroll
    for (int mi = 0; mi < 2; ++mi)
#pragma unroll
      for (int r = 0; r < 16; ++r) R[((wid * 2 + mi) * 16 + r) * 64 + lane] = (b == 0 ? acc[mi][0][r] : b == 1 ? acc[mi][1][r] : b == 2 ? acc[mi][2][r] : acc[mi][3][r]);
    __syncthreads();
    float y[8];
#pragma unroll
    for (int i = 0; i < 8; ++i) { const int r = 8 * rh + i; float s = 0.f;
#pragma unroll
      for (int q = 0; q < 4; ++q) s += R[(((tt1b + 2 * q) * 2 + tmi) * 16 + r) * 64 + lane];
      y[i] = s; }
    const bf16_t* x0r = F.HPT + (size_t)c * M + (size_t)b * L;
#pragma unroll
    for (int k = 0; k < 2; ++k) { const int t = 64 * (32 * tt1b + r32) + 32 * tmi + crow(8 * rh + 4 * k, hi);
      const u32x2 w = *(const u32x2*)(x0r + t); const float xm = t > 0 ? bf2f(x0r[t - 1]) : 0.f, xp = t + 4 < L ? bf2f(x0r[t + 4]) : 0.f;
      const float x0 = __uint_as_float(w.x << 16), x1 = __uint_as_float(w.x & 0xffff0000u), x2 = __uint_as_float(w.y << 16), x3 = __uint_as_float(w.y & 0xffff0000u);
      float o[4];
      o[0] = (xcb + xw0 * xm + xw1 * x0 + xw2 * x1) * y[4 * k + 0]; o[1] = (xcb + xw0 * x0 + xw1 * x1 + xw2 * x2) * y[4 * k + 1];
      o[2] = (xcb + xw0 * x1 + xw1 * x2 + xw2 * x3) * y[4 * k + 2]; o[3] = (xcb + xw0 * x2 + xw1 * x3 + xw2 * xp) * y[4 * k + 3];
      if (which == 0) { u32x2 pkd; pkd.x = cvt_pk_bf16(o[0], o[1]); pkd.y = cvt_pk_bf16(o[2], o[3]); *(LAS u32x2*)(OUT0 + b * L + t) = pkd; }
      else { const u32x2 p0 = *(const LAS u32x2*)(OUT0 + b * L + t);
        unsigned* yp = (unsigned*)(F.Y + (size_t)(b * L + t) * D + 512 + cpair0);
        yp[0] = (p0.x & 0xffffu) | (f2bf(o[0]) << 16); yp[D / 2] = (p0.x >> 16) | (f2bf(o[1]) << 16);
        yp[D] = (p0.y & 0xffffu) | (f2bf(o[2]) << 16); yp[3 * D / 2] = (p0.y >> 16) | (f2bf(o[3]) << 16); }
    }
    __syncthreads();
  }
}
}
__device__ __forceinline__ void phase_hyena(Frame& F) {
  for (int cp = F.bid; cp < 256; cp += F.G) { hy::channel(F, 2 * cp, 0, 2 * cp); hy::channel(F, 2 * cp + 1, 1, 2 * cp); }
}

constexpr int NPH = 12;
__global__ void __launch_bounds__(512, 2) mega(Args args) {
    extern __shared__ __attribute__((aligned(16))) unsigned char lds_raw[];
    Frame F;
    F.lds = (LAS unsigned char*)lds_raw; F.tid = threadIdx.x; F.lane = F.tid & 63; F.wave = __builtin_amdgcn_readfirstlane(F.tid >> 6); F.G = gridDim.x; F.bid = blockIdx.x;
    unsigned char* ws = args.ws; F.ws = ws; F.out = args.out;
    F.x = args.in[0]; F.c = args.in[1]; F.ctx = args.in[2]; F.c_ctx = args.in[3]; F.ada_w = args.in[4]; F.ada_b = args.in[5]; F.norm1_g = args.in[6]; F.norm2_g = args.in[7];
    F.w_in = args.in[8]; F.b_in = args.in[9]; F.w_out = args.in[10]; F.b_out = args.in[11]; F.lq1 = args.in[12]; F.lk1 = args.in[13]; F.lq2 = args.in[14]; F.lk2 = args.in[15];
    F.subln_g = args.in[16]; F.hy_cw = args.in[17]; F.hy_cb = args.in[18]; F.hy_w1 = args.in[19]; F.hy_b1 = args.in[20]; F.hy_f1 = args.in[21]; F.hy_w2 = args.in[22]; F.hy_b2 = args.in[23];
    F.hy_f2 = args.in[24]; F.hy_w3 = args.in[25]; F.hy_bias = args.in[26]; F.pool_w = args.in[27]; F.pool_scale = args.in[28]; F.mlp_w1 = args.in[29]; F.mlp_w2 = args.in[30]; F.final_g = args.in[31];
    F.MOD0 = (float*)(ws + OFF_MOD0); F.MOD1 = (float*)(ws + OFF_MOD1); F.SB1 = (float*)(ws + OFF_SB1); F.SSQ = (float*)(ws + OFF_SSQ); F.ROPE = (f32x2*)(ws + OFF_ROPE);
    F.GR = (bf16_t*)(ws + OFF_GR); F.WIN = (bf16_t*)(ws + OFF_WIN); F.WOUT = (bf16_t*)(ws + OFF_WOUT); F.W1 = (bf16_t*)(ws + OFF_W1); F.W2 = (bf16_t*)(ws + OFF_W2); F.WPOOL = (bf16_t*)(ws + OFF_WPOOL);
    F.XN = (bf16_t*)(ws + OFF_XN); F.XC = (bf16_t*)(ws + OFF_XC); F.QB = (bf16_t*)(ws + OFF_QB); F.KALL = (bf16_t*)(ws + OFF_KALL); F.VALL = (bf16_t*)(ws + OFF_VALL); F.HPT = (bf16_t*)(ws + OFF_HPT);
    F.Y = (bf16_t*)(ws + OFF_Y); F.H = (bf16_t*)(ws + OFF_H);
    volatile LAS unsigned* MISC = (volatile LAS unsigned*)(F.lds + MISC_OFF);
    if (F.tid < 32) MISC[F.tid] = 0u;
    __syncthreads();
    XcdBarrier bar = xcd_barrier_post((unsigned*)ws + CW_BAR + args.li * XCD_BAR_WORDS, MISC + 8);
    const int lo = args.ph_lo, hi = args.ph_hi;
#ifndef PH_MASK
#define PH_MASK 0xFFFF
#endif
#define IN(k) (((PH_MASK >> (k)) & 1) && lo <= (k) && (k) < hi)
#define SEAM(k) do { if (IN(k) && IN((k) + 1)) xcd_barrier(bar); } while (0)
    if (IN(0)) phase0a(F);
    SEAM(0);
    if (IN(1)) phase0b(F);
    SEAM(1);
    if (IN(2)) { pg8::Gemm g{F.XN, F.WIN, nullptr, nullptr, D, D, D, 0};
        { pg8::Sched S; S.init(M, 6 * 256, F.G, F.bid, 0, 0); pg8::EpiInproj E{F.b_in, F.ROPE, F.ws}; pg8::gemm_phase<pg8::EpiInproj, false>(F.lds, g, S, E); }
        { pg8::Sched S; S.init(M, 6 * 256, F.G, F.G - 1 - F.bid, 0, 6); pg8::EpiHy E{F.b_in, F.HPT}; pg8::gemm_phase<pg8::EpiHy, true>(F.lds, g, S, E); } }
    SEAM(2);
    if (IN(3)) { phase_attn(F); phase_hyena(F); }
    SEAM(3);
    if (IN(4)) { pg8::Gemm g{F.Y, F.WOUT, nullptr, nullptr, D, D, D, 0}; pg8::Sched S; S.init(M, D, F.G, F.bid, 0);
        pg8::EpiResid E{F.x, F.out, F.b_out, nullptr, F.MOD0, 2, F.norm2_g, 4, F.XN, F.SSQ}; pg8::gemm_phase<pg8::EpiResid>(F.lds, g, S, E); }
    SEAM(4);
    if (IN(5)) { pg8::Gemm g{F.XN, F.W1, nullptr, nullptr, D, D, D, 0}; pg8::Sched S; S.init(M, FF, F.G, F.bid, 0);
        pg8::EpiMlpUp E{F.SSQ, F.SB1, F.H}; pg8::gemm_phase<pg8::EpiMlpUp>(F.lds, g, S, E); }
    SEAM(5);
    if (IN(6)) { pg8::Gemm g{F.H, F.W2, nullptr, nullptr, FF, FF, FF, 0}; pg8::Sched S; S.init(M, D, F.G, F.bid, 0);
        pg8::EpiResid E{F.out, F.out, nullptr, nullptr, F.MOD0, 5, nullptr, 0, nullptr, F.SSQ + M}; pg8::gemm_phase<pg8::EpiResid>(F.lds, g, S, E); }
    SEAM(6);
    if (IN(7)) phase_dlt(F);
    SEAM(7);
    if (IN(8)) { pg8::Gemm g{F.XN, F.WPOOL, nullptr, nullptr, D, 256, 256, 256}; pg8::Sched S; S.init(M, D, F.G, F.bid, 0);
        pg8::EpiResid E{F.out, F.out, nullptr, F.pool_scale, F.MOD1, 2, F.norm2_g + D, 4, F.XN, F.SSQ + 2 * M}; pg8::gemm_phase<pg8::EpiResid>(F.lds, g, S, E); }
    SEAM(8);
    if (IN(9)) { pg8::Gemm g{F.XN, F.W1 + (size_t)D * FF, nullptr, nullptr, D, D, D, 0}; pg8::Sched S; S.init(M, FF, F.G, F.bid, 0);
        pg8::EpiMlpUp E{F.SSQ + 2 * M, F.SB1 + 4 * FF, F.H}; pg8::gemm_phase<pg8::EpiMlpUp>(F.lds, g, S, E); }
    SEAM(9);
    if (IN(10)) { pg8::Gemm g{F.H, F.W2 + (size_t)D * FF, nullptr, nullptr, FF, FF, FF, 0}; pg8::Sched S; S.init(M, D, F.G, F.bid, 0);
        pg8::EpiResid E{F.out, F.out, nullptr, nullptr, F.MOD1, 5, nullptr, 0, nullptr, F.SSQ + 3 * M}; pg8::gemm_phase<pg8::EpiResid>(F.lds, g, S, E); }
    SEAM(10);
    if (IN(11)) phase_final(F);
#undef IN
#undef SEAM
}

__global__ __launch_bounds__(256) void k_attn2(const bf16_t* QB, const bf16_t* KALL, const bf16_t* VALL, const float* lq1, const float* lk1, const float* lq2, const float* lk2, const float* sg, bf16_t* Y) {
    const int bh = blockIdx.y, b = bh >> 2, h = bh & 3, q = blockIdx.x * 64 + (threadIdx.x >> 2), qt = threadIdx.x & 3;
    float s1 = 0, s2 = 0; for (int i = 0; i < 64; ++i) { s1 += lq1[i] * lk1[i]; s2 += lq2[i] * lk2[i]; }
    const float lam = expf(s1) - expf(s2) + LAM_INIT;
    float o[32];
#pragma unroll
    for (int d = 0; d < 32; ++d) o[d] = 0.f;
    for (int c = 0; c < 2; ++c) {
        float qv[64], acc[32];
        const bf16_t* qp = QB + (size_t)(b * L + q) * 512 + h * 128 + c * 64;
#pragma unroll
        for (int d = 0; d < 64; ++d) qv[d] = bf2f(qp[d]);
#pragma unroll
        for (int d = 0; d < 32; ++d) acc[d] = 0.f;
        float m = -1e30f, l = 0.f;
        for (int j = 0; j < KEYS; ++j) {
            const bf16_t* kp = KALL + (size_t)(b * KEYS + j) * 512 + h * 128 + c * 64; const bf16_t* vp = VALL + (size_t)(b * KEYS + j) * 512 + h * 128 + qt * 32;
            float s = 0.f;
#pragma unroll
            for (int d = 0; d < 64; ++d) s += qv[d] * bf2f(kp[d]);
            const float mn = fmaxf(m, s), al = exp2f(m - mn), p = exp2f(s - mn);
            l = l * al + p; m = mn;
#pragma unroll
            for (int d = 0; d < 32; ++d) acc[d] = acc[d] * al + p * bf2f(vp[d]);
        }
        const float f = (c == 0 ? 1.f : -lam) / l;
#pragma unroll
        for (int d = 0; d < 32; ++d) o[d] += acc[d] * f;
    }
    float ss = 0.f;
#pragma unroll
    for (int d = 0; d < 32; ++d) ss += o[d] * o[d];
    ss += __shfl_xor(ss, 1); ss += __shfl_xor(ss, 2);
    const float rstd = rsqrtf(ss / 128.f + 1e-5f);
#pragma unroll
    for (int d = 0; d < 32; ++d) Y[(size_t)(b * L + q) * D + h * 128 + qt * 32 + d] = (bf16_t)f2bf(o[d] * rstd * sg[qt * 32 + d] * (1.f - LAM_INIT));
}
__global__ __launch_bounds__(256) void k_hy_pre2(const bf16_t* HPT, const float* cw, const float* cb, float* UT) {
    const int c = blockIdx.y, row = blockIdx.x * 256 + threadIdx.x, t = row & (L - 1);
    float pr[2];
    for (int q = 1; q < 3; ++q) { const int col = q * 512 + c; const bf16_t* p = HPT + (size_t)col * M + row;
        float a = cb[col] + cw[1536 + col] * bf2f(p[0]);
        if (t > 0) a += cw[col] * bf2f(p[-1]);
        if (t < L - 1) a += cw[2 * 1536 + col] * bf2f(p[1]);
        pr[q - 1] = a; }
    UT[(size_t)c * M + row] = pr[1] * pr[0];
}
__global__ __launch_bounds__(256) void k_longconv2(const bf16_t* HPT, const float* cw, const float* cb, const float* UT, const bf16_t* GR, const float* hb, bf16_t* Y) {
    const int c = blockIdx.y, row = blockIdx.x * 256 + threadIdx.x, t = row & (L - 1), b = row >> 12;
    const float* up = UT + (size_t)c * M + b * L; const bf16_t* gp = GR + (size_t)c * GRLEN + 4103 - t;
    float acc = 0.f;
    for (int s = 0; s < L; ++s) acc += bf2f((bf16_t)f2bf(up[s])) * bf2f(gp[s]);
    const bf16_t* p = HPT + (size_t)c * M + row;
    float x0 = cb[c] + cw[1536 + c] * bf2f(p[0]);
    if (t > 0) x0 += cw[c] * bf2f(p[-1]);
    if (t < L - 1) x0 += cw[2 * 1536 + c] * bf2f(p[1]);
    Y[(size_t)row * D + 512 + c] = (bf16_t)f2bf(x0 * (acc + hb[c] * up[t]));
}

static void launch_mega(const Args& a0, int lo, int hi, int li, int grid, hipStream_t stream) {
    Args a = a0; a.ph_lo = lo; a.ph_hi = hi; a.li = li;
    hipLaunchKernelGGL(mega, dim3(grid), dim3(512), LDS_BYTES, stream, a);
}
extern "C" void kernel_launch(void* const* d_in, const int* in_sizes, int n_in, void* d_out, int out_size, void* d_ws, size_t ws_size, hipStream_t stream) {
    static int grid = 0;
    if (grid == 0) {
        if (n_in != 32 || out_size != M * D || ws_size < WS_END) { fprintf(stderr, "kernel_launch: unexpected shapes (n_in %d out %d ws %zu)\n", n_in, out_size, ws_size); grid = -1; return; }
        int dev = 0, cus = 0;
        if (hipGetDevice(&dev) != hipSuccess || hipDeviceGetAttribute(&cus, hipDeviceAttributeMultiprocessorCount, dev) != hipSuccess) { grid = -1; return; }
        if (hipFuncSetAttribute((const void*)mega, hipFuncAttributeMaxDynamicSharedMemorySize, LDS_BYTES) != hipSuccess) { fprintf(stderr, "hipFuncSetAttribute failed\n"); grid = -1; return; }
        grid = cus;
    }
    if (grid < 0) return;
    hipMemsetAsync(d_ws, 0, CTL_ZERO_BYTES, stream);
    Args a{};
    for (int i = 0; i < 32; ++i) a.in[i] = (const float*)d_in[i];
    a.out = (float*)d_out; a.ws = (unsigned char*)d_ws;
    char* ws = (char*)d_ws;
    launch_mega(a, 0, NPH, 0, grid, stream);
}
```
